# Optimizing an MI355X kernel written in HIP

```python
import math
import jax, jax.numpy as jnp
from jax import lax
import numpy as np

D_MODEL = 1024
BATCH = 16
SEQ = 2048
DEPTH = 4

CTX_LEN = 256
GRID_W = 64
ATTN_HEADS = 4
QK_DIM = 64
V_DIM = 2 * QK_DIM
ATTN_WIDTH = ATTN_HEADS * V_DIM
QK_WIDTH = ATTN_HEADS * 2 * QK_DIM
CHUNK = 128
SG_GROUPS = 4
SG_GROUP_DIM = 128
SG_WIDTH = SG_GROUPS * SG_GROUP_DIM
D_FF = ((8 * D_MODEL // 3 + 255) // 256) * 256
Q_BLOCK = 128
ROPE_THETA = 10000.0
EPS = 1e-6

K_OFF = 0
V_OFF = K_OFF + QK_WIDTH
Q_OFF = V_OFF + ATTN_WIDTH
U_OFF = Q_OFF + QK_WIDTH
SGV_OFF = U_OFF + SG_WIDTH
GATE_OFF = SGV_OFF + SG_WIDTH
IN_WIDTH = GATE_OFF + 2 * D_MODEL

kernel_name = 'hybrid_diffattn_spatialgate_dit_block'


def rms_norm(x, g):
    xf = x.astype(jnp.float32)
    y = xf * lax.rsqrt(jnp.mean(xf * xf, axis=-1, keepdims=True) + EPS)
    return (y * g.astype(jnp.float32)).astype(x.dtype)


def layer_norm(x, g):
    xf = x.astype(jnp.float32)
    mu = jnp.mean(xf, axis=-1, keepdims=True)
    var = jnp.mean(jnp.square(xf - mu), axis=-1, keepdims=True)
    return ((xf - mu) * lax.rsqrt(var + EPS) * g.astype(jnp.float32)).astype(x.dtype)


def modulate(h, shift, scale):
    return h * (1 + scale) + shift


def axial_rope_tables(n_tokens, dtype):
    rows = n_tokens // GRID_W
    row = jnp.broadcast_to(jnp.arange(rows)[:, None], (rows, GRID_W)).reshape(-1).astype(jnp.float32)
    col = jnp.broadcast_to(jnp.arange(GRID_W)[None, :], (rows, GRID_W)).reshape(-1).astype(jnp.float32)
    half = QK_DIM // 2
    inv = 1.0 / (ROPE_THETA ** (jnp.arange(0, half, 2, dtype=jnp.float32) / half))
    ang_r = row[:, None] * inv[None, :]
    ang_c = col[:, None] * inv[None, :]
    return (jnp.cos(ang_r).astype(dtype), jnp.sin(ang_r).astype(dtype),
            jnp.cos(ang_c).astype(dtype), jnp.sin(ang_c).astype(dtype))


def rotate(x, cos, sin):
    x1, x2 = jnp.split(x, 2, axis=-1)
    return jnp.concatenate([x1 * cos - x2 * sin, x2 * cos + x1 * sin], axis=-1)


def apply_rope2d(x, tables):
    cr, sr, cc, sc = [t[None, :, None, None, :] for t in tables]
    half = QK_DIM // 2
    return jnp.concatenate([rotate(x[..., :half], cr, sr), rotate(x[..., half:], cc, sc)], axis=-1)


def diff_softmax_attend(q, k, v, lam):
    s = jnp.einsum('bqhmd,bkhmd->bhmqk', q, k).astype(jnp.float32) * (QK_DIM ** -0.5)
    p = jax.nn.softmax(s, axis=-1)
    p = p[:, :, 0] - lam * p[:, :, 1]
    return jnp.einsum('bhqk,bkhd->bqhd', p.astype(v.dtype), v)


def latent_diff_attention(q, k_all, v_all, lam):
    B, S = q.shape[0], q.shape[1]
    nb = S // Q_BLOCK
    qb = q.reshape(B, nb, Q_BLOCK, ATTN_HEADS, 2, QK_DIM).swapaxes(0, 1)
    out = lax.map(lambda blk: diff_softmax_attend(blk, k_all, v_all, lam), qb)
    return out.swapaxes(0, 1).reshape(B, S, ATTN_HEADS, V_DIM)


def diff_head_out(o, subln_g, lam_init):
    B, T = o.shape[0], o.shape[1]
    return (rms_norm(o, subln_g) * (1.0 - lam_init)).reshape(B, T, ATTN_WIDTH)


def spatial_gating(u, v, norm_g, w_s, b_s):
    B, T = v.shape[0], v.shape[1]
    vc = layer_norm(v, norm_g).reshape(B, T // CHUNK, CHUNK, SG_GROUPS, SG_GROUP_DIM)
    mixed = jnp.einsum('gpq,bnqgd->bnpgd', w_s, vc) + b_s.T[None, None, :, :, None]
    return u * mixed.reshape(B, T, SG_WIDTH)


def merge_branches(attn, sg, gates, w_a, w_sg, w_o):
    ga, gb = jnp.split(jax.nn.sigmoid(gates), 2, axis=-1)
    return (ga * (attn @ w_a) + gb * (sg @ w_sg)) @ w_o


def swiglu(h, w_in, w_out):
    a, b = jnp.split(h @ w_in, 2, axis=-1)
    return (jax.nn.silu(a) * b) @ w_out


def qk_heads(p):
    return p.reshape(p.shape[0], p.shape[1], ATTN_HEADS, 2, QK_DIM)


def v_heads(p):
    return p.reshape(p.shape[0], p.shape[1], ATTN_HEADS, V_DIM)


def setup_inputs(seed: int = 0) -> dict:
    key = jax.random.key(seed)
    ks = jax.random.split(key, 24)
    f32 = jnp.float32
    nrm = lambda k, shape, s: jax.random.normal(k, shape, f32) * s
    return {
        'x': nrm(ks[0], (BATCH, SEQ, D_MODEL), 1.0),
        'c': nrm(ks[1], (BATCH, D_MODEL), 1.0),
        'ctx': nrm(ks[2], (BATCH, CTX_LEN, D_MODEL), 1.0),
        'c_ctx': nrm(ks[3], (D_MODEL,), 1.0),
        'ada_w': nrm(ks[4], (DEPTH, D_MODEL, 6 * D_MODEL), 0.5 * D_MODEL ** -0.5),
        'ada_b': nrm(ks[5], (DEPTH, 6 * D_MODEL), 0.02),
        'norm1_g': 1.0 + nrm(ks[6], (DEPTH, D_MODEL), 0.02),
        'w_in': nrm(ks[7], (DEPTH, D_MODEL, IN_WIDTH), D_MODEL ** -0.5),
        'lambda_q1': nrm(ks[8], (DEPTH, QK_DIM), 0.1),
        'lambda_k1': nrm(ks[9], (DEPTH, QK_DIM), 0.1),
        'lambda_q2': nrm(ks[10], (DEPTH, QK_DIM), 0.1),
        'lambda_k2': nrm(ks[11], (DEPTH, QK_DIM), 0.1),
        'subln_g': 1.0 + nrm(ks[12], (DEPTH, V_DIM), 0.02),
        'sg_norm_g': 1.0 + nrm(ks[13], (DEPTH, SG_WIDTH), 0.02),
        'sg_w': nrm(ks[14], (DEPTH, SG_GROUPS, CHUNK, CHUNK), CHUNK ** -0.5),
        'sg_b': 1.0 + nrm(ks[15], (DEPTH, SG_GROUPS, CHUNK), 0.01),
        'w_branch_attn': nrm(ks[16], (DEPTH, ATTN_WIDTH, D_MODEL), ATTN_WIDTH ** -0.5),
        'w_branch_sg': nrm(ks[17], (DEPTH, SG_WIDTH, D_MODEL), SG_WIDTH ** -0.5),
        'w_out': nrm(ks[18], (DEPTH, D_MODEL, D_MODEL), D_MODEL ** -0.5),
        'norm2_g': 1.0 + nrm(ks[19], (DEPTH, D_MODEL), 0.02),
        'w_ffn_in': nrm(ks[20], (DEPTH, D_MODEL, 2 * D_FF), D_MODEL ** -0.5),
        'w_ffn_out': nrm(ks[21], (DEPTH, D_FF, D_MODEL), D_FF ** -0.5),
        'final_g': 1.0 + nrm(ks[22], (D_MODEL,), 0.02),
    }


def reference(x, c, ctx, c_ctx, ada_w, ada_b, norm1_g, w_in, lambda_q1, lambda_k1,
              lambda_q2, lambda_k2, subln_g, sg_norm_g, sg_w, sg_b, w_branch_attn,
              w_branch_sg, w_out, norm2_g, w_ffn_in, w_ffn_out, final_g):
    S = x.shape[1]
    tables = axial_rope_tables(S, x.dtype)
    silu_c = jax.nn.silu(c)
    silu_cc = jax.nn.silu(c_ctx)
    x_l, x_c = x, ctx
    for i in range(DEPTH):
        last = i == DEPTH - 1
        mod_l = (silu_c @ ada_w[i] + ada_b[i])[:, None, :]
        mod_c = silu_cc @ ada_w[i] + ada_b[i]
        sh1_l, sc1_l, g1_l, sh2_l, sc2_l, g2_l = jnp.split(mod_l, 6, axis=-1)
        sh1_c, sc1_c, g1_c, sh2_c, sc2_c, g2_c = jnp.split(mod_c, 6, axis=-1)
        lam_init = 0.8 - 0.6 * math.exp(-0.3 * i)
        lam = (jnp.exp(jnp.sum(lambda_q1[i].astype(jnp.float32) * lambda_k1[i].astype(jnp.float32)))
               - jnp.exp(jnp.sum(lambda_q2[i].astype(jnp.float32) * lambda_k2[i].astype(jnp.float32)))
               + lam_init)

        h_l = modulate(rms_norm(x_l, norm1_g[i]), sh1_l, sc1_l)
        h_c = modulate(rms_norm(x_c, norm1_g[i]), sh1_c, sc1_c)
        p_l = h_l @ w_in[i]
        p_c = h_c @ (w_in[i][:, :Q_OFF] if last else w_in[i])

        k_c = qk_heads(p_c[..., K_OFF:V_OFF])
        v_c = v_heads(p_c[..., V_OFF:Q_OFF])
        k_l = apply_rope2d(qk_heads(p_l[..., K_OFF:V_OFF]), tables)
        v_l = v_heads(p_l[..., V_OFF:Q_OFF])
        q_l = apply_rope2d(qk_heads(p_l[..., Q_OFF:U_OFF]), tables)
        k_all = jnp.concatenate([k_c, k_l], axis=1)
        v_all = jnp.concatenate([v_c, v_l], axis=1)

        attn_l = diff_head_out(latent_diff_attention(q_l, k_all, v_all, lam), subln_g[i], lam_init)
        sg_l = spatial_gating(jax.nn.gelu(p_l[..., U_OFF:SGV_OFF]), jax.nn.gelu(p_l[..., SGV_OFF:GATE_OFF]),
                              sg_norm_g[i], sg_w[i], sg_b[i])
        mix_l = merge_branches(attn_l, sg_l, p_l[..., GATE_OFF:], w_branch_attn[i], w_branch_sg[i], w_out[i])
        x_l = x_l + g1_l * mix_l

        if not last:
            q_c = qk_heads(p_c[..., Q_OFF:U_OFF])
            attn_c = diff_head_out(diff_softmax_attend(q_c, k_c, v_c, lam), subln_g[i], lam_init)
            sg_c = spatial_gating(jax.nn.gelu(p_c[..., U_OFF:SGV_OFF]), jax.nn.gelu(p_c[..., SGV_OFF:GATE_OFF]),
                                  sg_norm_g[i], sg_w[i], sg_b[i])
            mix_c = merge_branches(attn_c, sg_c, p_c[..., GATE_OFF:], w_branch_attn[i], w_branch_sg[i], w_out[i])
            x_c = x_c + g1_c * mix_c

        f_l = swiglu(modulate(rms_norm(x_l, norm2_g[i]), sh2_l, sc2_l), w_ffn_in[i], w_ffn_out[i])
        x_l = x_l + g2_l * f_l
        if not last:
            f_c = swiglu(modulate(rms_norm(x_c, norm2_g[i]), sh2_c, sc2_c), w_ffn_in[i], w_ffn_out[i])
            x_c = x_c + g2_c * f_c

    return rms_norm(x_l, final_g)
```

```cpp
#include <hip/hip_runtime.h>
#include <hip/hip_cooperative_groups.h>
#include <cstdio>
#include <cstdint>
#include <cmath>
namespace cg = cooperative_groups;
#ifndef COOP
#define COOP 1
#endif
namespace pg8 {
#define PG8_LAS __attribute__((address_space(3)))
typedef unsigned short bf16_t;
typedef short bf16x8 __attribute__((ext_vector_type(8)));
typedef float f32x4 __attribute__((ext_vector_type(4)));
typedef unsigned u32x4 __attribute__((ext_vector_type(4)));
constexpr int BM = 256, BK = 64, HALF = 128, HTB = HALF * BK * 2  , STAGE_BYTES = 8 * HTB, NXCD = 8, WGM = 8;

__host__ __device__ __forceinline__ int lds_byte(int r, int c) { const int st = (r >> 4) * 2 + (c >> 5), rr = r & 15, cc = c & 31, ob = rr * 64 + cc * 2; return st * 1024 + (ob ^ (((ob >> 9) & 1) << 5)); }
__host__ __device__ __forceinline__ void stage_rc(int b, int& R, int& C) { const int st = b / 1024, sb = b % 1024, swz = sb ^ (((sb >> 9) & 1) << 5); R = (st >> 1) * 16 + swz / 64; C = (st & 1) * 32 + (swz % 64) / 2; }
__host__ __device__ __forceinline__ int perm32(int rho) { const int n = rho >> 4, i = rho & 15; return 8 * (i >> 2) + 4 * n + (i & 3); }

struct Unit { int pm, pn; };
struct Gemm { const bf16_t* A; const bf16_t* Bt; int M, N, K; };

struct StaticOrder {
    int nM, nN, nwg, G, c;
    __host__ __device__ void init(int M, int N, int G_, int c_) { nM = M / BM; nN = N / BM; nwg = nM * nN; G = G_; c = c_; }
    __host__ __device__ bool next(int i, Unit& u) const {
        const long L = (long)i * G + c; if (L >= nwg) return false;
        int wgid = (int)L; { const int q = nwg / NXCD, r = nwg % NXCD, xcd = wgid % NXCD, off = wgid / NXCD; wgid = (xcd < r ? xcd * (q + 1) : r * (q + 1) + (xcd - r) * q) + off; }
        const int nig = WGM * nN, gid = wgid / nig, fm = gid * WGM, gsz = (nM - fm) < WGM ? (nM - fm) : WGM;
        u.pm = fm + ((wgid % nig) % gsz); u.pn = (wgid % nig) / gsz; return true;
    }
    __device__ __forceinline__ void a_ready(const Unit&) const {}
    __device__ __forceinline__ void done(const Unit&) const {}
};

__device__ __forceinline__ unsigned cvt_pk_bf16(float lo, float hi) { unsigned r; asm volatile("v_cvt_pk_bf16_f32 %0, %1, %2" : "=v"(r) : "v"(lo), "v"(hi)); return r; }
typedef float f32x2 __attribute__((ext_vector_type(2)));
template <class Epi, class Sched, bool ALIGN_EPI = false, bool SP2 = false>
__device__ __forceinline__ void gemm_phase(PG8_LAS unsigned char* lds, const Gemm g, const Sched& S, const Epi& E) {
    int tid_ = threadIdx.x; asm volatile("" : "+v"(tid_));
    const int tid = tid_, wid = __builtin_amdgcn_readfirstlane(tid >> 6), lane = tid & 63, wr = wid >> 2, wc = wid & 3, fr = lane & 15, fq = lane >> 4;
    const int K = g.K, nt = K / BK;
    unsigned voffA[2], voffB[2];
#pragma unroll
    for (int i = 0; i < 2; ++i) { int R, C; stage_rc(tid * 16 + i * 8192, R, C); const int Rb = Epi::PERM ? ((R & ~31) + perm32(R & 31)) : R;
        voffA[i] = (unsigned)(R * K + C) * 2u; voffB[i] = (unsigned)(Rb * K + C) * 2u; }
    const size_t kstep = (size_t)(BK * 2);
    const size_t hstep = (size_t)HALF * K * 2;
    const size_t tstep = 2 * hstep;
    const unsigned ldsw = (unsigned)wid * 1024u;
    const int aoff = lds_byte(wr * 64 + fr, fq * 8), boff = lds_byte(wc * 32 + fr, fq * 8);
#define PG8_SA(b, h) (((b) * 2 + (h)) * HTB)
#define PG8_SB(b, h) ((4 + (b) * 2 + (h)) * HTB)
#define PG8_STAGE(bufoff, gbase, voff) do { _Pragma("unroll") for (int _i = 0; _i < 2; ++_i) \
        __builtin_amdgcn_global_load_lds((const unsigned*)((const char*)(gbase) + (voff)[_i]), (PG8_LAS unsigned*)(lds + (bufoff) + ldsw + _i * 8192), 16, 0, 0); } while (0)
#define PG8_LDA(dst, b, h) do { _Pragma("unroll") for (int m = 0; m < 4; ++m) _Pragma("unroll") for (int k = 0; k < 2; ++k) dst[m][k] = *(const PG8_LAS bf16x8*)(lds + PG8_SA(b, h) + aoff + m * 2048 + k * 1024); } while (0)
#define PG8_LDB(dst, b, h) do { _Pragma("unroll") for (int n = 0; n < 2; ++n) _Pragma("unroll") for (int k = 0; k < 2; ++k) dst[n][k] = *(const PG8_LAS bf16x8*)(lds + PG8_SB(b, h) + boff + n * 2048 + k * 1024); } while (0)
#define PG8_MMA(ai, bj, At, Bt) do { __builtin_amdgcn_s_setprio(1); _Pragma("unroll") for (int m = 0; m < 4; ++m) _Pragma("unroll") for (int n = 0; n < 2; ++n) _Pragma("unroll") for (int k = 0; k < 2; ++k) \
        acc[ai][bj][m][n] = __builtin_amdgcn_mfma_f32_16x16x32_bf16(Bt[n][k], At[m][k], acc[ai][bj][m][n], 0, 0, 0); __builtin_amdgcn_s_setprio(0); } while (0)
#define PG8_WAIT_V(n) asm volatile("s_waitcnt vmcnt(" #n ")" ::: "memory")
#define PG8_WAIT_L(n) asm volatile("s_waitcnt lgkmcnt(" #n ")" ::: "memory")
#define PG8_BAR __builtin_amdgcn_s_barrier()
#define PG8_SCHED __builtin_amdgcn_sched_barrier(0)
    Unit cur, nxt; int ui = 0;
    if (!S.next(0, cur)) return;
    f32x4 acc[2][2][4][2];
#pragma unroll
    for (int a = 0; a < 2; ++a)
#pragma unroll
        for (int b = 0; b < 2; ++b)
#pragma unroll
            for (int m = 0; m < 4; ++m)
#pragma unroll
                for (int n = 0; n < 2; ++n) acc[a][b][m][n] = (f32x4){0.f, 0.f, 0.f, 0.f};
    bf16x8 At[4][2], B0[2][2], B1[2][2];
    const char* cA = (const char*)g.A + (size_t)cur.pm * tstep; const char* cB = (const char*)g.Bt + (size_t)cur.pn * tstep;
    S.a_ready(cur);
    if constexpr (SP2) {
        PG8_STAGE(PG8_SB(0, 0), cB, voffB); PG8_STAGE(PG8_SB(0, 1), cB + hstep, voffB); PG8_STAGE(PG8_SA(0, 0), cA, voffA); PG8_STAGE(PG8_SA(0, 1), cA + hstep, voffA);
        if (wr == 1) PG8_BAR;
        PG8_WAIT_V(2); PG8_BAR;
        PG8_STAGE(PG8_SB(1, 0), cB + kstep, voffB); PG8_STAGE(PG8_SA(1, 0), cA + kstep, voffA); PG8_STAGE(PG8_SB(1, 1), cB + hstep + kstep, voffB);
        PG8_WAIT_V(6); PG8_BAR;
    } else {
        PG8_STAGE(PG8_SB(0, 0), cB, voffB); PG8_STAGE(PG8_SA(0, 0), cA, voffA); PG8_STAGE(PG8_SB(0, 1), cB + hstep, voffB); PG8_STAGE(PG8_SA(0, 1), cA + hstep, voffA);
        if (wr == 1) PG8_BAR;
        PG8_WAIT_V(4); PG8_BAR;
        PG8_STAGE(PG8_SB(1, 0), cB + kstep, voffB); PG8_STAGE(PG8_SA(1, 0), cA + kstep, voffA); PG8_STAGE(PG8_SB(1, 1), cB + hstep + kstep, voffB);
        PG8_WAIT_V(6); PG8_BAR;
    }
    for (;;) {
        const bool has_next = S.next(ui + 1, nxt);
        const char* nA = has_next ? (const char*)g.A + (size_t)nxt.pm * tstep : cA; const char* nB = has_next ? (const char*)g.Bt + (size_t)nxt.pn * tstep : cB;
        for (int t = 0; t < nt; t += 2) {
            const bool last = (t == nt - 2);
            const char* a1 = cA + (size_t)(t + 1) * kstep;
            const char* a2 = last ? nA : cA + (size_t)(t + 2) * kstep; const char* b2 = last ? nB : cB + (size_t)(t + 2) * kstep;
            const char* a3 = a2 + kstep; const char* b3 = b2 + kstep;
            if (last && has_next) S.a_ready(nxt);
            if constexpr (SP2) {
            PG8_LDB(B0, 0, 0); PG8_LDB(B1, 0, 1); PG8_SCHED; PG8_LDA(At, 0, 0); PG8_STAGE(PG8_SA(1, 1), a1 + hstep, voffA);
            PG8_WAIT_V(8); PG8_WAIT_L(0); PG8_BAR; PG8_MMA(0, 0, At, B0); PG8_MMA(0, 1, At, B1); PG8_BAR; PG8_SCHED;
            PG8_LDA(At, 0, 1); PG8_STAGE(PG8_SB(0, 0), b2, voffB); PG8_STAGE(PG8_SB(0, 1), b2 + hstep, voffB); PG8_STAGE(PG8_SA(0, 0), a2, voffA);
            PG8_WAIT_V(8); PG8_WAIT_L(0); PG8_BAR; PG8_MMA(1, 0, At, B0); PG8_MMA(1, 1, At, B1); PG8_BAR; PG8_SCHED;
            PG8_LDB(B0, 1, 0); PG8_LDB(B1, 1, 1); PG8_SCHED; PG8_LDA(At, 1, 0); PG8_STAGE(PG8_SA(0, 1), a2 + hstep, voffA);
            PG8_WAIT_V(8); PG8_WAIT_L(0); PG8_BAR; PG8_MMA(0, 0, At, B0); PG8_MMA(0, 1, At, B1); PG8_BAR; PG8_SCHED;
            PG8_LDA(At, 1, 1); PG8_STAGE(PG8_SB(1, 0), b3, voffB); PG8_STAGE(PG8_SB(1, 1), b3 + hstep, voffB); PG8_STAGE(PG8_SA(1, 0), a3, voffA);
            PG8_WAIT_V(8); PG8_WAIT_L(0); PG8_BAR; PG8_MMA(1, 0, At, B0); PG8_MMA(1, 1, At, B1); PG8_BAR; PG8_SCHED;
            } else {
            PG8_LDB(B0, 0, 0); PG8_SCHED; PG8_LDA(At, 0, 0); PG8_STAGE(PG8_SA(1, 1), a1 + hstep, voffA);
            PG8_WAIT_L(8); PG8_BAR; PG8_WAIT_L(0); PG8_MMA(0, 0, At, B0); PG8_BAR; PG8_SCHED;
            PG8_LDB(B1, 0, 1); PG8_STAGE(PG8_SB(0, 0), b2, voffB);
            PG8_BAR; PG8_WAIT_L(0); PG8_MMA(0, 1, At, B1); PG8_BAR;
            PG8_LDA(At, 0, 1); PG8_STAGE(PG8_SA(0, 0), a2, voffA);
            PG8_BAR; PG8_WAIT_L(0); PG8_MMA(1, 0, At, B0); PG8_BAR; PG8_SCHED;
            PG8_STAGE(PG8_SB(0, 1), b2 + hstep, voffB);
            PG8_WAIT_V(6); PG8_BAR; PG8_MMA(1, 1, At, B1); PG8_BAR;
            PG8_LDB(B0, 1, 0); PG8_SCHED; PG8_LDA(At, 1, 0); PG8_STAGE(PG8_SA(0, 1), a2 + hstep, voffA);
            PG8_WAIT_L(8); PG8_BAR; PG8_WAIT_L(0); PG8_MMA(0, 0, At, B0); PG8_BAR; PG8_SCHED;
            PG8_LDB(B1, 1, 1); PG8_STAGE(PG8_SB(1, 0), b3, voffB);
            PG8_BAR; PG8_WAIT_L(0); PG8_MMA(0, 1, At, B1); PG8_BAR;
            PG8_LDA(At, 1, 1); PG8_STAGE(PG8_SA(1, 0), a3, voffA);
            PG8_BAR; PG8_WAIT_L(0); PG8_MMA(1, 0, At, B0); PG8_BAR; PG8_SCHED;
            PG8_STAGE(PG8_SB(1, 1), b3 + hstep, voffB);
            PG8_WAIT_V(6); PG8_BAR; PG8_MMA(1, 1, At, B1); PG8_BAR;
            }
        }
        if constexpr (ALIGN_EPI) { if (wr == 0) PG8_BAR; }
        if constexpr (!Epi::AFTER_DRAIN) { E(acc, cur, wr, wc, fr, fq); S.done(cur); }
        if (!has_next) break;
#pragma unroll
        for (int a = 0; a < 2; ++a)
#pragma unroll
            for (int b = 0; b < 2; ++b)
#pragma unroll
                for (int m = 0; m < 4; ++m)
#pragma unroll
                    for (int n = 0; n < 2; ++n) acc[a][b][m][n] = (f32x4){0.f, 0.f, 0.f, 0.f};
        cur = nxt; cA = nA; cB = nB; ++ui;
        if constexpr (ALIGN_EPI) { if (wr == 1) PG8_BAR; }
    }
    PG8_WAIT_V(0);
    if constexpr (!ALIGN_EPI) { if (wr == 0) PG8_BAR; }
    PG8_BAR;
    if constexpr (Epi::AFTER_DRAIN) { E.fused(acc, cur, wr, wc, fr, fq, lds, wid, lane); S.done(cur); }
#undef PG8_SA
#undef PG8_SB
#undef PG8_STAGE
#undef PG8_LDA
#undef PG8_LDB
#undef PG8_MMA
#undef PG8_WAIT_V
#undef PG8_WAIT_L
#undef PG8_BAR
#undef PG8_SCHED
}
}

#define LAS __attribute__((address_space(3)))
using pg8::bf16_t; using pg8::bf16x8; using pg8::f32x4; using pg8::u32x4; using pg8::Unit;
typedef float f32x16 __attribute__((ext_vector_type(16)));
typedef unsigned u32x2 __attribute__((ext_vector_type(2)));
constexpr int DM = 1024, NB = 16, SEQ = 2048, CTXL = 256, DEPTH = 4;
constexpr int RL = NB * SEQ, RC = NB * CTXL, RT = RL + RC;
constexpr int INW = 4608, DFF = 2816, NKEYS = CTXL + SEQ;
constexpr float QSCALE = 0.125f * 1.4426950408889634f;
constexpr float EPS = 1e-6f;
constexpr size_t MiB = (size_t)1 << 20;
constexpr size_t WS_ROPE = 65536, WS_LAM = 131072, WS_MOD = 1 * MiB, WS_SGW = 3 * MiB;
constexpr size_t WS_WIN = 4 * MiB, WS_WA = 13 * MiB, WS_WSG = 14 * MiB, WS_WO = 15 * MiB, WS_WF1 = 17 * MiB, WS_WF2 = 28 * MiB;
constexpr size_t WS_XC = 34 * MiB, WS_H = 50 * MiB;
constexpr size_t WS_K = 122 * MiB, WS_VT = 158 * MiB, WS_Q = 194 * MiB, WS_U = 230 * MiB, WS_SV = 266 * MiB, WS_G = 302 * MiB, WS_ACT = 122 * MiB;
constexpr size_t WS_END = 446 * MiB;
constexpr int LDS_BYTES = 147456;
constexpr int NPHASE = 2 + 8 * DEPTH;

struct Params { const float* in[23]; float* out; unsigned char* ws; float lam_init[4]; int lo, hi; };

__device__ __forceinline__ float bf2f(unsigned short b) { return __uint_as_float((unsigned)b << 16); }
__device__ __forceinline__ float bflo(unsigned w) { return __uint_as_float(w << 16); }
__device__ __forceinline__ float bfhi(unsigned w) { return __uint_as_float(w & 0xffff0000u); }
__device__ __forceinline__ unsigned pk2(float lo, float hi) { return pg8::cvt_pk_bf16(lo, hi); }
__device__ __forceinline__ float fast_exp2(float x) { return __builtin_amdgcn_exp2f(x); }
__device__ __forceinline__ float fast_rcp(float x) { return __builtin_amdgcn_rcpf(x); }
__device__ __forceinline__ float sigmoidf_(float x) { return fast_rcp(1.0f + fast_exp2(-1.4426950408889634f * x)); }
__device__ __forceinline__ float siluf_(float x) { return x * sigmoidf_(x); }
__device__ __forceinline__ float geluf_(float x) { const float u = x * (0.7978845608028654f + 0.035677408136300125f * x * x); return x * fast_rcp(1.0f + fast_exp2(-2.8853900817779268f * u)); }
__device__ __forceinline__ float wave_sum(float v) {
#pragma unroll
    for (int o = 1; o < 64; o <<= 1) v += __shfl_xor(v, o);
    return v;
}
#define LDS_WAIT() asm volatile("s_waitcnt lgkmcnt(0)" ::: "memory")

struct EpiG1 {
    static constexpr bool PERM = true, AFTER_DRAIN = false;
    bf16_t *Kb, *VT, *Qb, *Ub, *SVb, *Gb; const float* rope; int row_off;
    __device__ __forceinline__ void operator()(const f32x4 (&acc)[2][2][4][2], const Unit& u, int wr, int wc, int fr, int fq) const {
        const int rbase = row_off + u.pm * 256 + wr * 64 + fr;
        const bool latent = (row_off + u.pm * 256) < RL;
        const int pn = u.pn, cw = wc * 32 + 8 * fq;
        if (pn >= 6) {
            const bool gate = pn >= 10;
            bf16_t* base; int ld;
            if (gate) { base = Gb + (pn - 10) * 256 + cw; ld = 2048; } else { base = (pn < 8 ? Ub : SVb) + (pn & 1) * 256 + cw; ld = 512; }
#pragma unroll
            for (int ai = 0; ai < 2; ++ai)
#pragma unroll
                for (int m = 0; m < 4; ++m) { bf16_t* rowp = base + (size_t)(rbase + ai * 128 + m * 16) * ld;
#pragma unroll
                    for (int bj = 0; bj < 2; ++bj) { const f32x4 v0 = acc[ai][bj][m][0], v1 = acc[ai][bj][m][1]; float y[8];
#pragma unroll
                        for (int j = 0; j < 4; ++j) { y[j] = gate ? sigmoidf_(v0[j]) : geluf_(v0[j]); y[4 + j] = gate ? sigmoidf_(v1[j]) : geluf_(v1[j]); }
                        u32x4 w; w.x = pk2(y[0], y[1]); w.y = pk2(y[2], y[3]); w.z = pk2(y[4], y[5]); w.w = pk2(y[6], y[7]);
                        *(u32x4*)(rowp + bj * 128) = w; } }
        } else if (pn == 2 || pn == 3) {
#pragma unroll
            for (int ai = 0; ai < 2; ++ai)
#pragma unroll
                for (int m = 0; m < 4; ++m) { const int row = rbase + ai * 128 + m * 16; int b, key;
                    if (latent) { b = row >> 11; key = CTXL + (row & 2047); } else { const int rc = row - RL; b = rc >> 8; key = rc & 255; }
                    const int pos = (key & ~12) | ((key & 4) << 1) | ((key & 8) >> 1);
#pragma unroll
                    for (int bj = 0; bj < 2; ++bj) { const int head = (pn & 1) * 2 + bj; bf16_t* p = VT + ((size_t)((b * 4 + head) * 128 + cw)) * NKEYS + pos;
                        const f32x4 v0 = acc[ai][bj][m][0], v1 = acc[ai][bj][m][1];
                        const unsigned w0 = pk2(v0[0], v0[1]), w1 = pk2(v0[2], v0[3]), w2 = pk2(v1[0], v1[1]), w3 = pk2(v1[2], v1[3]);
                        p[0 * NKEYS] = (bf16_t)(w0 & 0xffff); p[1 * NKEYS] = (bf16_t)(w0 >> 16); p[2 * NKEYS] = (bf16_t)(w1 & 0xffff); p[3 * NKEYS] = (bf16_t)(w1 >> 16);
                        p[4 * NKEYS] = (bf16_t)(w2 & 0xffff); p[5 * NKEYS] = (bf16_t)(w2 >> 16); p[6 * NKEYS] = (bf16_t)(w3 & 0xffff); p[7 * NKEYS] = (bf16_t)(w3 >> 16); } }
        } else {
            const bool isq = pn >= 4; bf16_t* base = (isq ? Qb : Kb) + (pn & 1) * 256 + cw; const float sc = isq ? QSCALE : 1.0f;
#pragma unroll
            for (int ai = 0; ai < 2; ++ai)
#pragma unroll
                for (int m = 0; m < 4; ++m) { const int row = rbase + ai * 128 + m * 16;
                    f32x4 cs = (f32x4){1.f, 1.f, 1.f, 1.f}, sn = (f32x4){0.f, 0.f, 0.f, 0.f};
                    if (latent) { const int s = row & 2047, pos = (wc & 1) ? (s & 63) : (s >> 6); cs = *(const f32x4*)(rope + pos * 32 + 4 * fq); sn = *(const f32x4*)(rope + pos * 32 + 16 + 4 * fq); }
                    cs = cs * sc; sn = sn * sc;
#pragma unroll
                    for (int bj = 0; bj < 2; ++bj) { const f32x4 v0 = acc[ai][bj][m][0], v1 = acc[ai][bj][m][1]; u32x4 w;
                        w.x = pk2(v0[0] * cs[0] - v0[1] * sn[0], v0[1] * cs[0] + v0[0] * sn[0]);
                        w.y = pk2(v0[2] * cs[1] - v0[3] * sn[1], v0[3] * cs[1] + v0[2] * sn[1]);
                        w.z = pk2(v1[0] * cs[2] - v1[1] * sn[2], v1[1] * cs[2] + v1[0] * sn[2]);
                        w.w = pk2(v1[2] * cs[3] - v1[3] * sn[3], v1[3] * cs[3] + v1[2] * sn[3]);
                        *(u32x4*)(base + (size_t)row * 512 + bj * 128) = w; } }
        }
    }
};
template <int STEP> struct EpiMerge {
    static constexpr bool PERM = true, AFTER_DRAIN = false;
    const bf16_t* Gb; bf16_t* Mb;
    __device__ __forceinline__ void operator()(const f32x4 (&acc)[2][2][4][2], const Unit& u, int wr, int wc, int fr, int fq) const {
        const int rbase = u.pm * 256 + wr * 64 + fr, col0 = u.pn * 256 + wc * 32 + 8 * fq;
#pragma unroll
        for (int ai = 0; ai < 2; ++ai)
#pragma unroll
            for (int m = 0; m < 4; ++m) { const size_t row = (size_t)(rbase + ai * 128 + m * 16);
#pragma unroll
                for (int bj = 0; bj < 2; ++bj) { const f32x4 v0 = acc[ai][bj][m][0], v1 = acc[ai][bj][m][1];
                    const u32x4 g = *(const u32x4*)(Gb + row * 2048 + (STEP - 1) * 1024 + col0 + bj * 128);
                    bf16_t* mp = Mb + row * 1024 + col0 + bj * 128; float y[8];
                    y[0] = bflo(g.x) * v0[0]; y[1] = bfhi(g.x) * v0[1]; y[2] = bflo(g.y) * v0[2]; y[3] = bfhi(g.y) * v0[3];
                    y[4] = bflo(g.z) * v1[0]; y[5] = bfhi(g.z) * v1[1]; y[6] = bflo(g.w) * v1[2]; y[7] = bfhi(g.w) * v1[3];
                    if (STEP == 2) { const u32x4 t = *(const u32x4*)mp;
                        y[0] += bflo(t.x); y[1] += bfhi(t.x); y[2] += bflo(t.y); y[3] += bfhi(t.y); y[4] += bflo(t.z); y[5] += bfhi(t.z); y[6] += bflo(t.w); y[7] += bfhi(t.w); }
                    u32x4 w; w.x = pk2(y[0], y[1]); w.y = pk2(y[2], y[3]); w.z = pk2(y[4], y[5]); w.w = pk2(y[6], y[7]);
                    *(u32x4*)mp = w; } }
    }
};
struct EpiResid {
    static constexpr bool PERM = false, AFTER_DRAIN = false;
    const float* base_l; const float* base_c; float* out_l; float* out_c; const float* gate;
    __device__ __forceinline__ void operator()(const f32x4 (&acc)[2][2][4][2], const Unit& u, int wr, int wc, int fr, int fq) const {
        const int row0 = u.pm * 256; const bool latent = row0 < RL;
        const float* gp = gate + (size_t)(latent ? (row0 >> 11) : 16) * 6144;
        const float* bp = latent ? base_l + (size_t)row0 * DM : base_c + (size_t)(row0 - RL) * DM;
        float* op = latent ? out_l + (size_t)row0 * DM : out_c + (size_t)(row0 - RL) * DM;
        const int col0 = u.pn * 256 + wc * 32 + 4 * fq;
        f32x4 gv[2][2];
#pragma unroll
        for (int bj = 0; bj < 2; ++bj)
#pragma unroll
            for (int n = 0; n < 2; ++n) gv[bj][n] = *(const f32x4*)(gp + col0 + bj * 128 + n * 16);
#pragma unroll
        for (int ai = 0; ai < 2; ++ai)
#pragma unroll
            for (int m = 0; m < 4; ++m) { const size_t off = (size_t)(wr * 64 + fr + ai * 128 + m * 16) * DM + col0;
#pragma unroll
                for (int bj = 0; bj < 2; ++bj)
#pragma unroll
                    for (int n = 0; n < 2; ++n) { const f32x4 b = *(const f32x4*)(bp + off + bj * 128 + n * 16); *(f32x4*)(op + off + bj * 128 + n * 16) = b + gv[bj][n] * acc[ai][bj][m][n]; } }
    }
};
struct EpiFfn1 {
    static constexpr bool PERM = true, AFTER_DRAIN = false;
    bf16_t* act;
    __device__ __forceinline__ void operator()(const f32x4 (&acc)[2][2][4][2], const Unit& u, int wr, int wc, int fr, int fq) const {
        const int rbase = u.pm * 256 + wr * 64 + fr, col0 = u.pn * 128 + wc * 32 + 8 * fq;
#pragma unroll
        for (int ai = 0; ai < 2; ++ai)
#pragma unroll
            for (int m = 0; m < 4; ++m) { const f32x4 a0 = acc[ai][0][m][0], a1 = acc[ai][0][m][1], b0 = acc[ai][1][m][0], b1 = acc[ai][1][m][1]; float y[8];
#pragma unroll
                for (int j = 0; j < 4; ++j) { y[j] = siluf_(a0[j]) * b0[j]; y[4 + j] = siluf_(a1[j]) * b1[j]; }
                u32x4 w; w.x = pk2(y[0], y[1]); w.y = pk2(y[2], y[3]); w.z = pk2(y[4], y[5]); w.w = pk2(y[6], y[7]);
                *(u32x4*)(act + (size_t)(rbase + ai * 128 + m * 16) * DFF + col0) = w; }
    }
};

template <int MODE> __device__ __forceinline__ void transpose_item(const float* W, int K, int N, bf16_t* WT, LAS float* scr, int item, int lane) {
    const int nblk = N / 32, kb = item / nblk, nb = item % nblk, k0 = 64 * kb, n0 = 32 * nb, i = lane & 31;
    int srccol;
    if (MODE == 1) { const bool qk = (n0 < 512) || (n0 >= 1024 && n0 < 1536); srccol = n0 + (qk ? ((i & 1) * 16 + (i >> 1)) : i); }
    else if (MODE == 2) { const int pn = nb >> 3, half = (nb >> 2) & 1, jb = nb & 3; srccol = half * DFF + 128 * pn + 32 * jb + i; }
    else srccol = n0 + i;
#pragma unroll 8
    for (int t = 0; t < 32; ++t) { const int kk = 2 * t + (lane >> 5); scr[kk * 33 + i] = W[(size_t)(k0 + kk) * N + srccol]; }
    LDS_WAIT();
    const int c = lane & 7;
#pragma unroll
    for (int j = 0; j < 4; ++j) { const int n = (lane >> 3) + 8 * j; const LAS float* s = scr + (8 * c) * 33 + n;
        u32x4 o; o.x = pk2(s[0 * 33], s[1 * 33]); o.y = pk2(s[2 * 33], s[3 * 33]); o.z = pk2(s[4 * 33], s[5 * 33]); o.w = pk2(s[6 * 33], s[7 * 33]);
        *(u32x4*)(WT + (size_t)(n0 + n) * K + k0 + 8 * c) = o; }
    LDS_WAIT();
}
__device__ __forceinline__ void convert_layer_weights(const Params& p, int layer, LAS unsigned char* lds, int wid, int lane) {
    LAS float* scr = (LAS float*)(lds + wid * 8448);
    const int gw = blockIdx.x * 8 + wid, NGW = gridDim.x * 8;
    unsigned char* ws = p.ws;
    const float* w_in = p.in[7] + (size_t)layer * DM * INW; const float* w_a = p.in[16] + (size_t)layer * 512 * DM; const float* w_sg = p.in[17] + (size_t)layer * 512 * DM;
    const float* w_o = p.in[18] + (size_t)layer * DM * DM; const float* w_f1 = p.in[20] + (size_t)layer * DM * 2 * DFF; const float* w_f2 = p.in[21] + (size_t)layer * DFF * DM;
    constexpr int I_IN = 16 * 144, I_A = 8 * 32, I_O = 16 * 32, I_F1 = 16 * 176, I_F2 = 44 * 32, NIT = I_IN + 2 * I_A + I_O + I_F1 + I_F2;
    for (int it = gw; it < NIT; it += NGW) {
        int r = it;
        if (r < I_IN) { transpose_item<1>(w_in, DM, INW, (bf16_t*)(ws + WS_WIN), scr, r, lane); continue; } r -= I_IN;
        if (r < I_A) { transpose_item<0>(w_a, 512, DM, (bf16_t*)(ws + WS_WA), scr, r, lane); continue; } r -= I_A;
        if (r < I_A) { transpose_item<0>(w_sg, 512, DM, (bf16_t*)(ws + WS_WSG), scr, r, lane); continue; } r -= I_A;
        if (r < I_O) { transpose_item<0>(w_o, DM, DM, (bf16_t*)(ws + WS_WO), scr, r, lane); continue; } r -= I_O;
        if (r < I_F1) { transpose_item<2>(w_f1, DM, 2 * DFF, (bf16_t*)(ws + WS_WF1), scr, r, lane); continue; } r -= I_F1;
        transpose_item<0>(w_f2, DFF, DM, (bf16_t*)(ws + WS_WF2), scr, r, lane);
    }
}
__device__ __forceinline__ void norm_row(const float* xrow, bf16_t* hrow, const float* g, const float* sh, const float* sc, int lane) {
    f32x4 v[4]; float ss = 0.f;
#pragma unroll
    for (int j = 0; j < 4; ++j) { v[j] = ((const f32x4*)xrow)[lane + 64 * j]; ss += (v[j].x * v[j].x + v[j].y * v[j].y) + (v[j].z * v[j].z + v[j].w * v[j].w); }
    const float rstd = 1.0f / sqrtf(wave_sum(ss) * (1.0f / DM) + EPS);
#pragma unroll
    for (int j = 0; j < 4; ++j) { const f32x4 gg = ((const f32x4*)g)[lane + 64 * j], s1 = ((const f32x4*)sc)[lane + 64 * j], s0 = ((const f32x4*)sh)[lane + 64 * j];
        const f32x4 y = (v[j] * rstd) * gg * (s1 + 1.0f) + s0;
        u32x2 w; w.x = pk2(y.x, y.y); w.y = pk2(y.z, y.w); ((u32x2*)hrow)[lane + 64 * j] = w; }
}
__device__ __forceinline__ void norm_phase(const Params& p, int layer, int which  , int nrows, int wid, int lane) {
    const float* xl = (layer == 0 && which == 0) ? p.in[0] : p.out;
    const float* xc = (layer == 0 && which == 0) ? p.in[2] : (const float*)(p.ws + WS_XC);
    const float* g = (which == 0 ? p.in[6] : p.in[19]) + layer * DM;
    const float* mod = (const float*)(p.ws + WS_MOD) + (size_t)layer * 17 * 6144 + (which == 0 ? 0 : 3) * DM;
    bf16_t* H = (bf16_t*)(p.ws + WS_H);
    const int gw = blockIdx.x * 8 + wid, NGW = gridDim.x * 8;
    for (int r = gw; r < nrows; r += NGW) {
        const bool latent = r < RL; const int vec = latent ? (r >> 11) : 16;
        const float* xr = latent ? xl + (size_t)r * DM : xc + (size_t)(r - RL) * DM;
        norm_row(xr, H + (size_t)r * DM, g, mod + (size_t)vec * 6144, mod + (size_t)vec * 6144 + DM, lane);
    }
}
__device__ __forceinline__ void prologue_phase(const Params& p, LAS unsigned char* lds, int tid, int wid, int lane) {
    LAS float* sct = (LAS float*)lds;
    LAS float* red = (LAS float*)(lds + 81920);
    const float* c = p.in[1]; const float* cctx = p.in[3];
    for (int idx = tid; idx < 17 * 1024; idx += 512) { const int v = idx >> 10, k = idx & 1023; const float cv = (v < 16) ? c[v * 1024 + k] : cctx[k]; sct[k * 20 + v] = cv / (1.0f + expf(-cv)); }
    __syncthreads();
    float* mod = (float*)(p.ws + WS_MOD);
    for (int it = blockIdx.x; it < 4 * 96; it += gridDim.x) {
        const int layer = it / 96, nb = it % 96;
        const float* W = p.in[4] + (size_t)layer * DM * 6144 + nb * 64 + lane;
        float acc[17];
#pragma unroll
        for (int v = 0; v < 17; ++v) acc[v] = 0.f;
#pragma unroll 4
        for (int kk = 0; kk < 128; ++kk) { const int k = wid * 128 + kk; const float w = W[(size_t)k * 6144];
            const LAS f32x4* s4 = (const LAS f32x4*)(sct + k * 20);
            const f32x4 a = s4[0], b = s4[1], cc = s4[2], d = s4[3], e = s4[4];
            acc[0] += w * a.x; acc[1] += w * a.y; acc[2] += w * a.z; acc[3] += w * a.w; acc[4] += w * b.x; acc[5] += w * b.y; acc[6] += w * b.z; acc[7] += w * b.w;
            acc[8] += w * cc.x; acc[9] += w * cc.y; acc[10] += w * cc.z; acc[11] += w * cc.w; acc[12] += w * d.x; acc[13] += w * d.y; acc[14] += w * d.z; acc[15] += w * d.w; acc[16] += w * e.x; }
#pragma unroll
        for (int v = 0; v < 17; ++v) red[(wid * 17 + v) * 64 + lane] = acc[v];
        __syncthreads();
        for (int o = tid; o < 17 * 64; o += 512) { const int v = o >> 6, l = o & 63; float s = 0.f;
#pragma unroll
            for (int w = 0; w < 8; ++w) s += red[(w * 17 + v) * 64 + l];
            mod[((size_t)layer * 17 + v) * 6144 + nb * 64 + l] = s + p.in[5][layer * 6144 + nb * 64 + l]; }
        __syncthreads();
    }
    if (blockIdx.x == 0) {
        float* rope = (float*)(p.ws + WS_ROPE);
        for (int t = tid; t < 1024; t += 512) { const int pos = t >> 4, m = t & 15;
            double pw = 1.0; for (int i = 0; i < (m >> 2); ++i) pw *= 10.0;
            pw *= (m & 3) == 0 ? 1.0 : (m & 3) == 1 ? 1.7782794100389228 : (m & 3) == 2 ? 3.1622776601683795 : 5.623413251903491;
            const float inv = 1.0f / (float)pw; const float angf = (float)pos * inv;
            double a = (double)angf; const double twopi = 6.283185307179586476925286766559; a -= twopi * rint(a / twopi);
            double sn = 0.0, cs = 0.0, term = 1.0;
            for (int n = 0; n < 30; n += 2) { cs += ((n & 2) ? -term : term); term *= a / (double)(n + 1); sn += ((n & 2) ? -term : term); term *= a / (double)(n + 2); }
            rope[pos * 32 + m] = (float)cs; rope[pos * 32 + 16 + m] = (float)sn; }
    }
    if (blockIdx.x == 1 && wid < 4) {
        const float a = p.in[8][wid * 64 + lane] * p.in[9][wid * 64 + lane], b = p.in[10][wid * 64 + lane] * p.in[11][wid * 64 + lane];
        const float sa = wave_sum(a), sb = wave_sum(b);
        if (lane == 0) ((float*)(p.ws + WS_LAM))[wid] = expf(sa) - expf(sb) + ((const LAS float*)(lds + 143360 + 200))[wid];
    }
    { bf16_t* sgw = (bf16_t*)(p.ws + WS_SGW); const float* src = p.in[14];
      for (int i = blockIdx.x * 512 + tid; i < 4 * 4 * 128 * 128 / 2; i += gridDim.x * 512) ((unsigned*)sgw)[i] = pk2(src[2 * i], src[2 * i + 1]); }
}

struct AttnArgs { const bf16_t* Q; const bf16_t* K; const bf16_t* VT; bf16_t* O; const float* subln; float lam, oscale; };
constexpr int AKB = 64 * 272, AVB = 128 * 144;
__device__ __forceinline__ void attn_unit(LAS unsigned char* lds, const AttnArgs& a, int b, int h, int qrow0, int ntiles, int tid, int wid, int lane) {
    const int qb = wid >> 1, mp = wid & 1, r32 = lane & 31, hi = lane >> 5;
    const int kch = tid & 15, krow = tid >> 4, vch = tid & 7, vrow = tid >> 3;
    const bf16_t* kctx = a.K + (size_t)(RL + b * CTXL + krow) * 512 + h * 128 + kch * 8;
    const bf16_t* klat = a.K + (size_t)(b * SEQ + krow) * 512 + h * 128 + kch * 8;
    const bf16_t* vsrc = a.VT + ((size_t)((b * 4 + h) * 128 + vrow)) * NKEYS + vch * 8;
    u32x4 kr0, kr1, vr0, vr1;
#define ATT_LOAD(j) do { const bf16_t* kp_ = ((j) < 4) ? kctx + (size_t)(64 * (j)) * 512 : klat + (size_t)(64 * ((j) - 4)) * 512; \
        kr0 = *(const u32x4*)kp_; kr1 = *(const u32x4*)(kp_ + 32 * 512); vr0 = *(const u32x4*)(vsrc + 64 * (j)); vr1 = *(const u32x4*)(vsrc + (size_t)64 * NKEYS + 64 * (j)); } while (0)
#define ATT_STORE(buf) do { *(LAS u32x4*)(lds + (buf) * AKB + krow * 272 + kch * 16) = kr0; *(LAS u32x4*)(lds + (buf) * AKB + (krow + 32) * 272 + kch * 16) = kr1; \
        *(LAS u32x4*)(lds + 2 * AKB + (buf) * AVB + vrow * 144 + vch * 16) = vr0; *(LAS u32x4*)(lds + 2 * AKB + (buf) * AVB + (vrow + 64) * 144 + vch * 16) = vr1; } while (0)
    ATT_LOAD(0);
    bf16x8 qf[4];
    { const bf16_t* qp = a.Q + (size_t)(qrow0 + qb * 32 + r32) * 512 + h * 128 + mp * 64 + hi * 8;
#pragma unroll
      for (int ks = 0; ks < 4; ++ks) qf[ks] = *(const bf16x8*)(qp + ks * 16); }
    ATT_STORE(0);
    __syncthreads();
    f32x16 o[4];
#pragma unroll
    for (int d = 0; d < 4; ++d)
#pragma unroll
        for (int r = 0; r < 16; ++r) o[d][r] = 0.f;
    float mrun = -1e30f, lsum = 0.f;
    for (int j = 0; j < ntiles; ++j) {
        const int cur = j & 1;
        if (j + 1 < ntiles) ATT_LOAD(j + 1);
        f32x16 s0, s1;
#pragma unroll
        for (int r = 0; r < 16; ++r) { s0[r] = 0.f; s1[r] = 0.f; }
        const LAS unsigned char* Kp = lds + cur * AKB + r32 * 272 + (mp * 64 + hi * 8) * 2;
#pragma unroll
        for (int ks = 0; ks < 4; ++ks) {
            const bf16x8 k0 = *(const LAS bf16x8*)(Kp + ks * 32), k1 = *(const LAS bf16x8*)(Kp + 32 * 272 + ks * 32);
            s0 = __builtin_amdgcn_mfma_f32_32x32x16_bf16(k0, qf[ks], s0, 0, 0, 0);
            s1 = __builtin_amdgcn_mfma_f32_32x32x16_bf16(k1, qf[ks], s1, 0, 0, 0);
        }
        float mx = fmaxf(s0[0], s1[0]);
#pragma unroll
        for (int r = 1; r < 16; ++r) mx = fmaxf(mx, fmaxf(s0[r], s1[r]));
        mx = fmaxf(mx, __shfl_xor(mx, 32));
        const float mnew = fmaxf(mrun, mx), alpha = fast_exp2(mrun - mnew); mrun = mnew;
        float ps = 0.f;
#pragma unroll
        for (int r = 0; r < 16; ++r) { s0[r] = fast_exp2(s0[r] - mnew); s1[r] = fast_exp2(s1[r] - mnew); ps += s0[r] + s1[r]; }
        lsum = lsum * alpha + ps;
#pragma unroll
        for (int d = 0; d < 4; ++d)
#pragma unroll
            for (int r = 0; r < 16; ++r) o[d][r] *= alpha;
        bf16x8 pf[4];
        { u32x4 w;
          w.x = pk2(s0[0], s0[1]); w.y = pk2(s0[2], s0[3]); w.z = pk2(s0[4], s0[5]); w.w = pk2(s0[6], s0[7]); pf[0] = __builtin_bit_cast(bf16x8, w);
          w.x = pk2(s0[8], s0[9]); w.y = pk2(s0[10], s0[11]); w.z = pk2(s0[12], s0[13]); w.w = pk2(s0[14], s0[15]); pf[1] = __builtin_bit_cast(bf16x8, w);
          w.x = pk2(s1[0], s1[1]); w.y = pk2(s1[2], s1[3]); w.z = pk2(s1[4], s1[5]); w.w = pk2(s1[6], s1[7]); pf[2] = __builtin_bit_cast(bf16x8, w);
          w.x = pk2(s1[8], s1[9]); w.y = pk2(s1[10], s1[11]); w.z = pk2(s1[12], s1[13]); w.w = pk2(s1[14], s1[15]); pf[3] = __builtin_bit_cast(bf16x8, w); }
        const LAS unsigned char* Vp = lds + 2 * AKB + cur * AVB + r32 * 144 + hi * 16;
#pragma unroll
        for (int d = 0; d < 4; ++d)
#pragma unroll
            for (int s4 = 0; s4 < 4; ++s4) { const bf16x8 vf = *(const LAS bf16x8*)(Vp + d * 32 * 144 + s4 * 32); o[d] = __builtin_amdgcn_mfma_f32_32x32x16_bf16(vf, pf[s4], o[d], 0, 0, 0); }
        if (j + 1 < ntiles) ATT_STORE(cur ^ 1);
        __syncthreads();
    }
#undef ATT_LOAD
#undef ATT_STORE
    const float ltot = lsum + __shfl_xor(lsum, 32), inv = 1.0f / ltot;
    LAS float* X = (LAS float*)lds;
    if (mp == 1) {
#pragma unroll
        for (int d = 0; d < 4; ++d)
#pragma unroll
            for (int r = 0; r < 16; ++r) X[(qb * 64 + d * 16 + r) * 64 + lane] = o[d][r] * inv;
    }
    __syncthreads();
    if (mp == 0) {
        float ss = 0.f;
#pragma unroll
        for (int d = 0; d < 4; ++d)
#pragma unroll
            for (int r = 0; r < 16; ++r) { const float v = o[d][r] * inv - a.lam * X[(qb * 64 + d * 16 + r) * 64 + lane]; o[d][r] = v; ss += v * v; }
        ss += __shfl_xor(ss, 32);
        const float rn = a.oscale / sqrtf(ss * (1.0f / 128.0f) + EPS);
        bf16_t* op = a.O + (size_t)(qrow0 + qb * 32 + r32) * 512 + h * 128 + 4 * hi;
#pragma unroll
        for (int d = 0; d < 4; ++d)
#pragma unroll
            for (int g4 = 0; g4 < 4; ++g4) { const f32x4 gv = *(const f32x4*)(a.subln + d * 32 + 8 * g4 + 4 * hi);
                u32x2 w; w.x = pk2(o[d][4 * g4] * rn * gv.x, o[d][4 * g4 + 1] * rn * gv.y); w.y = pk2(o[d][4 * g4 + 2] * rn * gv.z, o[d][4 * g4 + 3] * rn * gv.w);
                *(u32x2*)(op + d * 32 + 8 * g4) = w; }
    }
    __syncthreads();
}
__device__ __forceinline__ void sg_unit(LAS unsigned char* lds, int R0, const bf16_t* SV, bf16_t* U, const float* ng, const bf16_t* sgw, const float* sgb, int tid, int wid, int lane) {
    LAS float* st = (LAS float*)(lds + 139264);
    for (int i = 0; i < 16; ++i) { const int row = wid * 16 + i;
        const u32x4 x = *(const u32x4*)(SV + (size_t)(R0 + row) * 512 + lane * 8);
        const float f0 = bflo(x.x), f1 = bfhi(x.x), f2 = bflo(x.y), f3 = bfhi(x.y), f4 = bflo(x.z), f5 = bfhi(x.z), f6 = bflo(x.w), f7 = bfhi(x.w);
        const float mean = wave_sum(((f0 + f1) + (f2 + f3)) + ((f4 + f5) + (f6 + f7))) * (1.0f / 512.0f);
        const float d0 = f0 - mean, d1 = f1 - mean, d2 = f2 - mean, d3 = f3 - mean, d4 = f4 - mean, d5 = f5 - mean, d6 = f6 - mean, d7 = f7 - mean;
        const float var = wave_sum(((d0 * d0 + d1 * d1) + (d2 * d2 + d3 * d3)) + ((d4 * d4 + d5 * d5) + (d6 * d6 + d7 * d7))) * (1.0f / 512.0f);
        if (lane == 0) { st[row * 2] = mean; st[row * 2 + 1] = 1.0f / sqrtf(var + EPS); } }
    __syncthreads();
    { const f32x4 sv = *(const LAS f32x4*)(st + lane * 4);
      for (int t = 0; t < 8; ++t) { const int cb = wid * 8 + t;
        const u32x4 x0 = *(const u32x4*)(SV + (size_t)(R0 + 2 * lane) * 512 + cb * 8), x1 = *(const u32x4*)(SV + (size_t)(R0 + 2 * lane + 1) * 512 + cb * 8);
        const f32x4 g0 = *(const f32x4*)(ng + cb * 8), g1 = *(const f32x4*)(ng + cb * 8 + 4);
        LAS unsigned char* wp = lds + (cb * 8) * 272 + lane * 4;
        *(LAS unsigned*)(wp + 0 * 272) = pk2((bflo(x0.x) - sv.x) * sv.y * g0.x, (bflo(x1.x) - sv.z) * sv.w * g0.x);
        *(LAS unsigned*)(wp + 1 * 272) = pk2((bfhi(x0.x) - sv.x) * sv.y * g0.y, (bfhi(x1.x) - sv.z) * sv.w * g0.y);
        *(LAS unsigned*)(wp + 2 * 272) = pk2((bflo(x0.y) - sv.x) * sv.y * g0.z, (bflo(x1.y) - sv.z) * sv.w * g0.z);
        *(LAS unsigned*)(wp + 3 * 272) = pk2((bfhi(x0.y) - sv.x) * sv.y * g0.w, (bfhi(x1.y) - sv.z) * sv.w * g0.w);
        *(LAS unsigned*)(wp + 4 * 272) = pk2((bflo(x0.z) - sv.x) * sv.y * g1.x, (bflo(x1.z) - sv.z) * sv.w * g1.x);
        *(LAS unsigned*)(wp + 5 * 272) = pk2((bfhi(x0.z) - sv.x) * sv.y * g1.y, (bfhi(x1.z) - sv.z) * sv.w * g1.y);
        *(LAS unsigned*)(wp + 6 * 272) = pk2((bflo(x0.w) - sv.x) * sv.y * g1.z, (bflo(x1.w) - sv.z) * sv.w * g1.z);
        *(LAS unsigned*)(wp + 7 * 272) = pk2((bfhi(x0.w) - sv.x) * sv.y * g1.w, (bfhi(x1.w) - sv.z) * sv.w * g1.w); } }
    __syncthreads();
    { const int g = wid >> 1, ph = wid & 1, r32 = lane & 31, hi = lane >> 5;
      for (int pbi = 0; pbi < 2; ++pbi) { const int pcol = (ph * 2 + pbi) * 32 + r32;
        f32x16 acc[4];
#pragma unroll
        for (int d = 0; d < 4; ++d)
#pragma unroll
            for (int r = 0; r < 16; ++r) acc[d][r] = 0.f;
        const bf16_t* wrow = sgw + ((size_t)g * 128 + pcol) * 128 + hi * 8;
        const LAS unsigned char* ap = lds + (g * 128 + r32) * 272 + hi * 16;
#pragma unroll
        for (int ks = 0; ks < 8; ++ks) { const bf16x8 bf = *(const bf16x8*)(wrow + ks * 16);
#pragma unroll
            for (int d = 0; d < 4; ++d) { const bf16x8 af = *(const LAS bf16x8*)(ap + d * 32 * 272 + ks * 32); acc[d] = __builtin_amdgcn_mfma_f32_32x32x16_bf16(af, bf, acc[d], 0, 0, 0); } }
        const float bias = sgb[g * 128 + pcol];
        bf16_t* up = U + (size_t)(R0 + pcol) * 512 + g * 128 + 4 * hi;
#pragma unroll
        for (int d = 0; d < 4; ++d)
#pragma unroll
            for (int g4 = 0; g4 < 4; ++g4) { const u32x2 uu = *(const u32x2*)(up + d * 32 + 8 * g4);
                u32x2 w; w.x = pk2(bflo(uu.x) * (acc[d][4 * g4] + bias), bfhi(uu.x) * (acc[d][4 * g4 + 1] + bias)); w.y = pk2(bflo(uu.y) * (acc[d][4 * g4 + 2] + bias), bfhi(uu.y) * (acc[d][4 * g4 + 3] + bias));
                *(u32x2*)(up + d * 32 + 8 * g4) = w; } } }
    __syncthreads();
}
__device__ __forceinline__ void mixer_phase(const Params& p, int layer, bool last, LAS unsigned char* lds, int tid, int wid, int lane) {
    AttnArgs a; a.Q = (const bf16_t*)(p.ws + WS_Q); a.K = (const bf16_t*)(p.ws + WS_K); a.VT = (const bf16_t*)(p.ws + WS_VT); a.O = (bf16_t*)(p.ws + WS_Q);
    a.subln = p.in[12] + layer * 128; a.lam = ((const float*)(p.ws + WS_LAM))[layer]; a.oscale = 1.0f - ((const LAS float*)(lds + 143360 + 200))[layer];
    const int n_ctx_att = last ? 0 : 128, n_sg = last ? 256 : 288, n_items = 1024 + n_ctx_att + n_sg, G = gridDim.x;
    for (int it = blockIdx.x; it < n_items; it += G) {
        if (it < 1024) {
            int bh, qblk;
            if (G == 256) { const int c = it & 255, round = it >> 8, x = c & 7, slot = c >> 3; bh = round * 16 + x * 2 + (slot >> 4); qblk = slot & 15; } else { bh = it >> 4; qblk = it & 15; }
            attn_unit(lds, a, bh >> 2, bh & 3, (bh >> 2) * SEQ + qblk * 128, 36, tid, wid, lane);
        } else if (it < 1024 + n_ctx_att) { const int r = it - 1024, bh = r >> 1, half = r & 1;
            attn_unit(lds, a, bh >> 2, bh & 3, RL + (bh >> 2) * CTXL + half * 128, 4, tid, wid, lane);
        } else { const int n = it - 1024 - n_ctx_att;
            sg_unit(lds, n * 128, (const bf16_t*)(p.ws + WS_SV), (bf16_t*)(p.ws + WS_U), p.in[13] + layer * 512, (const bf16_t*)(p.ws + WS_SGW) + (size_t)layer * 4 * 128 * 128, p.in[15] + layer * 512, tid, wid, lane);
        }
    }
}
__device__ __forceinline__ void final_phase(const Params& p, int wid, int lane) {
    const float* g = p.in[22]; const int gw = blockIdx.x * 8 + wid, NGW = gridDim.x * 8;
    for (int r = gw; r < RL; r += NGW) { float* xr = p.out + (size_t)r * DM;
        f32x4 v[4]; float ss = 0.f;
#pragma unroll
        for (int j = 0; j < 4; ++j) { v[j] = ((const f32x4*)xr)[lane + 64 * j]; ss += (v[j].x * v[j].x + v[j].y * v[j].y) + (v[j].z * v[j].z + v[j].w * v[j].w); }
        const float rstd = 1.0f / sqrtf(wave_sum(ss) * (1.0f / DM) + EPS);
#pragma unroll
        for (int j = 0; j < 4; ++j) ((f32x4*)xr)[lane + 64 * j] = (v[j] * rstd) * ((const f32x4*)g)[lane + 64 * j]; }
}

constexpr int LDSP_OFF = 143360;
__device__ __forceinline__ unsigned long long ldsp64(LAS const unsigned* P, int i) {
    const unsigned lo = __builtin_amdgcn_readfirstlane(P[2 * i]), hi = __builtin_amdgcn_readfirstlane(P[2 * i + 1]); return ((unsigned long long)hi << 32) | lo; }
__device__ __forceinline__ Params load_params(LAS unsigned char* lds) {
    LAS const unsigned* P = (LAS const unsigned*)(lds + LDSP_OFF);
    Params q;
    q.in[0] = (const float*)(const __attribute__((address_space(1))) float*)ldsp64(P, 0);
    q.in[1] = (const float*)(const __attribute__((address_space(1))) float*)ldsp64(P, 1);
    q.in[2] = (const float*)(const __attribute__((address_space(1))) float*)ldsp64(P, 2);
    q.in[3] = (const float*)(const __attribute__((address_space(1))) float*)ldsp64(P, 3);
    q.in[4] = (const float*)(const __attribute__((address_space(1))) float*)ldsp64(P, 4);
    q.in[5] = (const float*)(const __attribute__((address_space(1))) float*)ldsp64(P, 5);
    q.in[6] = (const float*)(const __attribute__((address_space(1))) float*)ldsp64(P, 6);
    q.in[7] = (const float*)(const __attribute__((address_space(1))) float*)ldsp64(P, 7);
    q.in[8] = (const float*)(const __attribute__((address_space(1))) float*)ldsp64(P, 8);
    q.in[9] = (const float*)(const __attribute__((address_space(1))) float*)ldsp64(P, 9);
    q.in[10] = (const float*)(const __attribute__((address_space(1))) float*)ldsp64(P, 10);
    q.in[11] = (const float*)(const __attribute__((address_space(1))) float*)ldsp64(P, 11);
    q.in[12] = (const float*)(const __attribute__((address_space(1))) float*)ldsp64(P, 12);
    q.in[13] = (const float*)(const __attribute__((address_space(1))) float*)ldsp64(P, 13);
    q.in[14] = (const float*)(const __attribute__((address_space(1))) float*)ldsp64(P, 14);
    q.in[15] = (const float*)(const __attribute__((address_space(1))) float*)ldsp64(P, 15);
    q.in[16] = (const float*)(const __attribute__((address_space(1))) float*)ldsp64(P, 16);
    q.in[17] = (const float*)(const __attribute__((address_space(1))) float*)ldsp64(P, 17);
    q.in[18] = (const float*)(const __attribute__((address_space(1))) float*)ldsp64(P, 18);
    q.in[19] = (const float*)(const __attribute__((address_space(1))) float*)ldsp64(P, 19);
    q.in[20] = (const float*)(const __attribute__((address_space(1))) float*)ldsp64(P, 20);
    q.in[21] = (const float*)(const __attribute__((address_space(1))) float*)ldsp64(P, 21);
    q.in[22] = (const float*)(const __attribute__((address_space(1))) float*)ldsp64(P, 22);
    q.out = (float*)(__attribute__((address_space(1))) float*)ldsp64(P, 23); q.ws = (unsigned char*)(__attribute__((address_space(1))) unsigned char*)ldsp64(P, 24);
    q.lam_init[0] = __uint_as_float(__builtin_amdgcn_readfirstlane(P[50]));
    q.lam_init[1] = __uint_as_float(__builtin_amdgcn_readfirstlane(P[51]));
    q.lam_init[2] = __uint_as_float(__builtin_amdgcn_readfirstlane(P[52]));
    q.lam_init[3] = __uint_as_float(__builtin_amdgcn_readfirstlane(P[53]));
    q.lo = 0; q.hi = 0;
    return q;
}
__global__ void __launch_bounds__(512) fwd_kernel(Params kp) {
    extern __shared__ __attribute__((aligned(16))) unsigned char lds_raw[];
    LAS unsigned char* lds = (LAS unsigned char*)lds_raw;
    const int G = gridDim.x, lo = kp.lo, hi = kp.hi;
    if (threadIdx.x == 0) { LAS unsigned long long* P = (LAS unsigned long long*)(lds + LDSP_OFF);
        P[0] = (unsigned long long)kp.in[0];
        P[1] = (unsigned long long)kp.in[1];
        P[2] = (unsigned long long)kp.in[2];
        P[3] = (unsigned long long)kp.in[3];
        P[4] = (unsigned long long)kp.in[4];
        P[5] = (unsigned long long)kp.in[5];
        P[6] = (unsigned long long)kp.in[6];
        P[7] = (unsigned long long)kp.in[7];
        P[8] = (unsigned long long)kp.in[8];
        P[9] = (unsigned long long)kp.in[9];
        P[10] = (unsigned long long)kp.in[10];
        P[11] = (unsigned long long)kp.in[11];
        P[12] = (unsigned long long)kp.in[12];
        P[13] = (unsigned long long)kp.in[13];
        P[14] = (unsigned long long)kp.in[14];
        P[15] = (unsigned long long)kp.in[15];
        P[16] = (unsigned long long)kp.in[16];
        P[17] = (unsigned long long)kp.in[17];
        P[18] = (unsigned long long)kp.in[18];
        P[19] = (unsigned long long)kp.in[19];
        P[20] = (unsigned long long)kp.in[20];
        P[21] = (unsigned long long)kp.in[21];
        P[22] = (unsigned long long)kp.in[22];
        P[23] = (unsigned long long)kp.out; P[24] = (unsigned long long)kp.ws;
        LAS float* Pf = (LAS float*)(lds + LDSP_OFF + 200);
        Pf[0] = kp.lam_init[0]; Pf[1] = kp.lam_init[1]; Pf[2] = kp.lam_init[2]; Pf[3] = kp.lam_init[3]; }
    __syncthreads();
#define FRESH() int tid = threadIdx.x; asm volatile("" : "+v"(tid)); const int lane = tid & 63, wid = __builtin_amdgcn_readfirstlane(tid >> 6); (void)lane; (void)wid; (void)tid; const Params p = load_params(lds); unsigned char* ws = p.ws; (void)ws
    int ph = 0;
#ifndef PHM
#define PHM 0xffff
#endif
#define RUNS(k) ((k) >= lo && (k) < hi)
#define SEAM() do { if (RUNS(ph) && RUNS(ph + 1)) { cg::this_grid().sync(); } ++ph; } while (0)
    if ((PHM & 1) && RUNS(ph)) { FRESH(); prologue_phase(p, lds, tid, wid, lane); __syncthreads(); convert_layer_weights(p, 0, lds, wid, lane); }
    SEAM();
    for (int layer = 0; layer < DEPTH; ++layer) {
        const bool last = layer == DEPTH - 1;
        const int M = last ? RL : RT;
        if ((PHM & 2) && RUNS(ph)) { FRESH(); if (layer > 0) convert_layer_weights(p, layer, lds, wid, lane); norm_phase(p, layer, 0, RT, wid, lane); }
        SEAM();
        if ((PHM & 4) && RUNS(ph)) { FRESH();
            EpiG1 E{(bf16_t*)(ws + WS_K), (bf16_t*)(ws + WS_VT), (bf16_t*)(ws + WS_Q), (bf16_t*)(ws + WS_U), (bf16_t*)(ws + WS_SV), (bf16_t*)(ws + WS_G), (const float*)(ws + WS_ROPE), 0};
            pg8::Gemm g{(const bf16_t*)(ws + WS_H), (const bf16_t*)(ws + WS_WIN), M, INW, DM}; pg8::StaticOrder S; S.init(M, INW, G, (int)blockIdx.x);
            pg8::gemm_phase<EpiG1, pg8::StaticOrder, true, true>(lds, g, S, E);
            if (last) {
                EpiG1 E2 = E; E2.row_off = RL;
                pg8::Gemm g2{(const bf16_t*)(ws + WS_H) + (size_t)RL * DM, (const bf16_t*)(ws + WS_WIN), RC, 1024, DM}; pg8::StaticOrder S2; S2.init(RC, 1024, G, (int)blockIdx.x);
                pg8::gemm_phase<EpiG1, pg8::StaticOrder, true, true>(lds, g2, S2, E2);
            }
        }
        SEAM();
        if ((PHM & 8) && RUNS(ph)) { FRESH(); mixer_phase(p, layer, last, lds, tid, wid, lane); }
        SEAM();
        if ((PHM & 16) && RUNS(ph)) { FRESH();
            pg8::StaticOrder S; S.init(M, DM, G, (int)blockIdx.x);
            { EpiMerge<1> E{(const bf16_t*)(ws + WS_G), (bf16_t*)(ws + WS_H)}; pg8::Gemm g{(const bf16_t*)(ws + WS_Q), (const bf16_t*)(ws + WS_WA), M, DM, 512};
              pg8::gemm_phase<EpiMerge<1>, pg8::StaticOrder, true, true>(lds, g, S, E); }
            { EpiMerge<2> E{(const bf16_t*)(ws + WS_G), (bf16_t*)(ws + WS_H)}; pg8::Gemm g{(const bf16_t*)(ws + WS_U), (const bf16_t*)(ws + WS_WSG), M, DM, 512};
              pg8::gemm_phase<EpiMerge<2>, pg8::StaticOrder, true, true>(lds, g, S, E); }
        }
        SEAM();
        if ((PHM & 32) && RUNS(ph)) { FRESH();
            const float* modl = (const float*)(ws + WS_MOD) + (size_t)layer * 17 * 6144;
            const float* xl_in = layer == 0 ? p.in[0] : p.out; const float* xc_in = layer == 0 ? p.in[2] : (const float*)(ws + WS_XC);
            EpiResid E{xl_in, xc_in, p.out, (float*)(ws + WS_XC), modl + 2 * DM};
            pg8::Gemm g{(const bf16_t*)(ws + WS_H), (const bf16_t*)(ws + WS_WO), M, DM, DM}; pg8::StaticOrder S; S.init(M, DM, G, (int)blockIdx.x);
            pg8::gemm_phase<EpiResid, pg8::StaticOrder, true, true>(lds, g, S, E);
        }
        SEAM();
        if ((PHM & 64) && RUNS(ph)) { FRESH(); norm_phase(p, layer, 1, M, wid, lane); }
        SEAM();
        if ((PHM & 128) && RUNS(ph)) { FRESH();
            EpiFfn1 E{(bf16_t*)(ws + WS_ACT)};
            pg8::Gemm g{(const bf16_t*)(ws + WS_H), (const bf16_t*)(ws + WS_WF1), M, 2 * DFF, DM}; pg8::StaticOrder S; S.init(M, 2 * DFF, G, (int)blockIdx.x);
            pg8::gemm_phase<EpiFfn1, pg8::StaticOrder, true, true>(lds, g, S, E);
        }
        SEAM();
        if ((PHM & 256) && RUNS(ph)) { FRESH();
            const float* modl = (const float*)(ws + WS_MOD) + (size_t)layer * 17 * 6144;
            EpiResid E{p.out, (const float*)(ws + WS_XC), p.out, (float*)(ws + WS_XC), modl + 5 * DM};
            pg8::Gemm g{(const bf16_t*)(ws + WS_ACT), (const bf16_t*)(ws + WS_WF2), M, DM, DFF}; pg8::StaticOrder S; S.init(M, DM, G, (int)blockIdx.x);
            pg8::gemm_phase<EpiResid, pg8::StaticOrder, true, true>(lds, g, S, E);
        }
        SEAM();
    }
    if ((PHM & 512) && RUNS(ph)) { FRESH(); final_phase(p, wid, lane); }
#undef RUNS
#undef SEAM
}

extern "C" void kernel_launch(void* const* d_in, const int* in_sizes, int n_in, void* d_out, int out_size, void* d_ws, size_t ws_size, hipStream_t stream) {
    static int grid = 0;
    if (grid == 0) {
        if (n_in != 23 || out_size != RL * DM || ws_size < WS_END) { fprintf(stderr, "kernel_launch: unexpected shapes (n_in %d out %d ws %zu)\n", n_in, out_size, ws_size); grid = -1; return; }
        int dev = 0, cus = 0, per_cu = 0;
        hipGetDevice(&dev); hipDeviceGetAttribute(&cus, hipDeviceAttributeMultiprocessorCount, dev);
        if (hipFuncSetAttribute((const void*)fwd_kernel, hipFuncAttributeMaxDynamicSharedMemorySize, LDS_BYTES) != hipSuccess) { fprintf(stderr, "kernel_launch: hipFuncSetAttribute failed\n"); grid = -1; return; }
        if (hipOccupancyMaxActiveBlocksPerMultiprocessor(&per_cu, (const void*)fwd_kernel, 512, LDS_BYTES) != hipSuccess || per_cu < 1) { fprintf(stderr, "kernel_launch: occupancy query says %d\n", per_cu); per_cu = 1; }
        (void)hipGetLastError();
        grid = cus * per_cu;
        if (grid > 256) grid = 256;
    }
    if (grid < 0) return;
    Params p{};
    for (int i = 0; i < 23; ++i) p.in[i] = (const float*)d_in[i];
    p.out = (float*)d_out; p.ws = (unsigned char*)d_ws;
    for (int i = 0; i < 4; ++i) p.lam_init[i] = (float)(0.8 - 0.6 * std::exp(-0.3 * (double)i));
#if COOP
    p.lo = 0; p.hi = NPHASE;
    void* args[] = {&p};
    hipError_t e = hipLaunchCooperativeKernel((const void*)fwd_kernel, dim3(grid), dim3(512), args, LDS_BYTES, stream);
    if (e != hipSuccess) fprintf(stderr, "cooperative launch failed: %s (grid %d)\n", hipGetErrorString(e), grid);
#else
    for (int k = 0; k < NPHASE; ++k) { p.lo = k; p.hi = k + 1; hipLaunchKernelGGL(fwd_kernel, dim3(grid), dim3(512), LDS_BYTES, stream, p); }
#endif
}
```

```cpp
#include <hip/hip_runtime.h>
#include <hip/hip_cooperative_groups.h>
#include <cstdio>
#include <cstdint>
#include <cmath>
namespace cg = cooperative_groups;
#ifndef COOP
#define COOP 1
#endif
#ifndef DUP_GEMM
#define DUP_GEMM 0
#endif
#ifndef DUP_ATTN
#define DUP_ATTN 0
#endif
namespace pg8 {
#define PG8_LAS __attribute__((address_space(3)))
typedef unsigned short bf16_t;
typedef short bf16x8 __attribute__((ext_vector_type(8)));
typedef float f32x4 __attribute__((ext_vector_type(4)));
typedef unsigned u32x4 __attribute__((ext_vector_type(4)));
constexpr int BM = 256, BK = 64, HALF = 128, HTB = HALF * BK * 2  , STAGE_BYTES = 8 * HTB, NXCD = 8, WGM = 8;

__host__ __device__ __forceinline__ int lds_byte(int r, int c) { const int st = (r >> 4) * 2 + (c >> 5), rr = r & 15, cc = c & 31, ob = rr * 64 + cc * 2; return st * 1024 + (ob ^ (((ob >> 9) & 1) << 5)); }
__host__ __device__ __forceinline__ void stage_rc(int b, int& R, int& C) { const int st = b / 1024, sb = b % 1024, swz = sb ^ (((sb >> 9) & 1) << 5); R = (st >> 1) * 16 + swz / 64; C = (st & 1) * 32 + (swz % 64) / 2; }
__host__ __device__ __forceinline__ int perm32(int rho) { const int n = rho >> 4, i = rho & 15; return 8 * (i >> 2) + 4 * n + (i & 3); }

struct Unit { int pm, pn; };
struct Gemm { const bf16_t* A; const bf16_t* Bt; int M, N, K; };

struct StaticOrder {
    int nM, nN, nwg, G, c;
    __host__ __device__ void init(int M, int N, int G_, int c_) { nM = M / BM; nN = N / BM; nwg = nM * nN; G = G_; c = c_; }
    __host__ __device__ bool next(int i, Unit& u) const {
        const long L = (long)i * G + c; if (L >= nwg) return false;
        int wgid = (int)L; { const int q = nwg / NXCD, r = nwg % NXCD, xcd = wgid % NXCD, off = wgid / NXCD; wgid = (xcd < r ? xcd * (q + 1) : r * (q + 1) + (xcd - r) * q) + off; }
        const int nig = WGM * nN, gid = wgid / nig, fm = gid * WGM, gsz = (nM - fm) < WGM ? (nM - fm) : WGM;
        u.pm = fm + ((wgid % nig) % gsz); u.pn = (wgid % nig) / gsz; return true;
    }
    __device__ __forceinline__ void a_ready(const Unit&) const {}
    __device__ __forceinline__ void done(const Unit&) const {}
};

__device__ __forceinline__ unsigned cvt_pk_bf16(float lo, float hi) { unsigned r; asm volatile("v_cvt_pk_bf16_f32 %0, %1, %2" : "=v"(r) : "v"(lo), "v"(hi)); return r; }
typedef float f32x2 __attribute__((ext_vector_type(2)));
template <class Epi, class Sched, bool ALIGN_EPI = false, bool SP2 = false>
__device__ __forceinline__ void gemm_phase(PG8_LAS unsigned char* lds, const Gemm g, const Sched& S, const Epi& E) {
    int tid_ = threadIdx.x; asm volatile("" : "+v"(tid_));
    const int tid = tid_, wid = __builtin_amdgcn_readfirstlane(tid >> 6), lane = tid & 63, wr = wid >> 2, wc = wid & 3, fr = lane & 15, fq = lane >> 4;
    const int K = g.K, nt = K / BK;
    unsigned voffA[2], voffB[2];
#pragma unroll
    for (int i = 0; i < 2; ++i) { int R, C; stage_rc(tid * 16 + i * 8192, R, C); const int Rb = Epi::PERM ? ((R & ~31) + perm32(R & 31)) : R;
        voffA[i] = (unsigned)(R * K + C) * 2u; voffB[i] = (unsigned)(Rb * K + C) * 2u; }
    const size_t kstep = (size_t)(BK * 2);
    const size_t hstep = (size_t)HALF * K * 2;
    const size_t tstep = 2 * hstep;
    const unsigned ldsw = (unsigned)wid * 1024u;
    const int aoff = lds_byte(wr * 64 + fr, fq * 8), boff = lds_byte(wc * 32 + fr, fq * 8);
#define PG8_SA(b, h) (((b) * 2 + (h)) * HTB)
#define PG8_SB(b, h) ((4 + (b) * 2 + (h)) * HTB)
#define PG8_STAGE(bufoff, gbase, voff) do { _Pragma("unroll") for (int _i = 0; _i < 2; ++_i) \
        __builtin_amdgcn_global_load_lds((const unsigned*)((const char*)(gbase) + (voff)[_i]), (PG8_LAS unsigned*)(lds + (bufoff) + ldsw + _i * 8192), 16, 0, 0); } while (0)
#define PG8_LDA(dst, b, h) do { _Pragma("unroll") for (int m = 0; m < 4; ++m) _Pragma("unroll") for (int k = 0; k < 2; ++k) dst[m][k] = *(const PG8_LAS bf16x8*)(lds + PG8_SA(b, h) + aoff + m * 2048 + k * 1024); } while (0)
#define PG8_LDB(dst, b, h) do { _Pragma("unroll") for (int n = 0; n < 2; ++n) _Pragma("unroll") for (int k = 0; k < 2; ++k) dst[n][k] = *(const PG8_LAS bf16x8*)(lds + PG8_SB(b, h) + boff + n * 2048 + k * 1024); } while (0)
#define PG8_MMA(ai, bj, At, Bt) do { __builtin_amdgcn_s_setprio(1); _Pragma("unroll") for (int m = 0; m < 4; ++m) _Pragma("unroll") for (int n = 0; n < 2; ++n) _Pragma("unroll") for (int k = 0; k < 2; ++k) \
        acc[ai][bj][m][n] = __builtin_amdgcn_mfma_f32_16x16x32_bf16(Bt[n][k], At[m][k], acc[ai][bj][m][n], 0, 0, 0); __builtin_amdgcn_s_setprio(0); } while (0)
#define PG8_WAIT_V(n) asm volatile("s_waitcnt vmcnt(" #n ")" ::: "memory")
#define PG8_WAIT_L(n) asm volatile("s_waitcnt lgkmcnt(" #n ")" ::: "memory")
#define PG8_BAR __builtin_amdgcn_s_barrier()
#define PG8_SCHED __builtin_amdgcn_sched_barrier(0)
    Unit cur, nxt; int ui = 0;
    if (!S.next(0, cur)) return;
    f32x4 acc[2][2][4][2];
#pragma unroll
    for (int a = 0; a < 2; ++a)
#pragma unroll
        for (int b = 0; b < 2; ++b)
#pragma unroll
            for (int m = 0; m < 4; ++m)
#pragma unroll
                for (int n = 0; n < 2; ++n) acc[a][b][m][n] = (f32x4){0.f, 0.f, 0.f, 0.f};
    bf16x8 At[4][2], B0[2][2], B1[2][2];
    const char* cA = (const char*)g.A + (size_t)cur.pm * tstep; const char* cB = (const char*)g.Bt + (size_t)cur.pn * tstep;
    S.a_ready(cur);
    if constexpr (SP2) {
        PG8_STAGE(PG8_SB(0, 0), cB, voffB); PG8_STAGE(PG8_SB(0, 1), cB + hstep, voffB); PG8_STAGE(PG8_SA(0, 0), cA, voffA); PG8_STAGE(PG8_SA(0, 1), cA + hstep, voffA);
        if (wr == 1) PG8_BAR;
        PG8_WAIT_V(2); PG8_BAR;
        PG8_STAGE(PG8_SB(1, 0), cB + kstep, voffB); PG8_STAGE(PG8_SA(1, 0), cA + kstep, voffA); PG8_STAGE(PG8_SB(1, 1), cB + hstep + kstep, voffB);
        PG8_WAIT_V(6); PG8_BAR;
    } else {
        PG8_STAGE(PG8_SB(0, 0), cB, voffB); PG8_STAGE(PG8_SA(0, 0), cA, voffA); PG8_STAGE(PG8_SB(0, 1), cB + hstep, voffB); PG8_STAGE(PG8_SA(0, 1), cA + hstep, voffA);
        if (wr == 1) PG8_BAR;
        PG8_WAIT_V(4); PG8_BAR;
        PG8_STAGE(PG8_SB(1, 0), cB + kstep, voffB); PG8_STAGE(PG8_SA(1, 0), cA + kstep, voffA); PG8_STAGE(PG8_SB(1, 1), cB + hstep + kstep, voffB);
        PG8_WAIT_V(6); PG8_BAR;
    }
    for (;;) {
        const bool has_next = S.next(ui + 1, nxt);
        const char* nA = has_next ? (const char*)g.A + (size_t)nxt.pm * tstep : cA; const char* nB = has_next ? (const char*)g.Bt + (size_t)nxt.pn * tstep : cB;
        for (int t = 0; t < nt; t += 2) {
            const bool last = (t == nt - 2);
            const char* a1 = cA + (size_t)(t + 1) * kstep;
            const char* a2 = last ? nA : cA + (size_t)(t + 2) * kstep; const char* b2 = last ? nB : cB + (size_t)(t + 2) * kstep;
            const char* a3 = a2 + kstep; const char* b3 = b2 + kstep;
            if (last && has_next) S.a_ready(nxt);
            if constexpr (SP2) {
            PG8_LDB(B0, 0, 0); PG8_LDB(B1, 0, 1); PG8_SCHED; PG8_LDA(At, 0, 0); PG8_STAGE(PG8_SA(1, 1), a1 + hstep, voffA);
            PG8_WAIT_V(8); PG8_WAIT_L(0); PG8_BAR; PG8_MMA(0, 0, At, B0); PG8_MMA(0, 1, At, B1); PG8_BAR; PG8_SCHED;
            PG8_LDA(At, 0, 1); PG8_STAGE(PG8_SB(0, 0), b2, voffB); PG8_STAGE(PG8_SB(0, 1), b2 + hstep, voffB); PG8_STAGE(PG8_SA(0, 0), a2, voffA);
            PG8_WAIT_V(8); PG8_WAIT_L(0); PG8_BAR; PG8_MMA(1, 0, At, B0); PG8_MMA(1, 1, At, B1); PG8_BAR; PG8_SCHED;
            PG8_LDB(B0, 1, 0); PG8_LDB(B1, 1, 1); PG8_SCHED; PG8_LDA(At, 1, 0); PG8_STAGE(PG8_SA(0, 1), a2 + hstep, voffA);
            PG8_WAIT_V(8); PG8_WAIT_L(0); PG8_BAR; PG8_MMA(0, 0, At, B0); PG8_MMA(0, 1, At, B1); PG8_BAR; PG8_SCHED;
            PG8_LDA(At, 1, 1); PG8_STAGE(PG8_SB(1, 0), b3, voffB); PG8_STAGE(PG8_SB(1, 1), b3 + hstep, voffB); PG8_STAGE(PG8_SA(1, 0), a3, voffA);
            PG8_WAIT_V(8); PG8_WAIT_L(0); PG8_BAR; PG8_MMA(1, 0, At, B0); PG8_MMA(1, 1, At, B1); PG8_BAR; PG8_SCHED;
            } else {
            PG8_LDB(B0, 0, 0); PG8_SCHED; PG8_LDA(At, 0, 0); PG8_STAGE(PG8_SA(1, 1), a1 + hstep, voffA);
            PG8_WAIT_L(8); PG8_BAR; PG8_WAIT_L(0); PG8_MMA(0, 0, At, B0); PG8_BAR; PG8_SCHED;
            PG8_LDB(B1, 0, 1); PG8_STAGE(PG8_SB(0, 0), b2, voffB);
            PG8_BAR; PG8_WAIT_L(0); PG8_MMA(0, 1, At, B1); PG8_BAR;
            PG8_LDA(At, 0, 1); PG8_STAGE(PG8_SA(0, 0), a2, voffA);
            PG8_BAR; PG8_WAIT_L(0); PG8_MMA(1, 0, At, B0); PG8_BAR; PG8_SCHED;
            PG8_STAGE(PG8_SB(0, 1), b2 + hstep, voffB);
            PG8_WAIT_V(6); PG8_BAR; PG8_MMA(1, 1, At, B1); PG8_BAR;
            PG8_LDB(B0, 1, 0); PG8_SCHED; PG8_LDA(At, 1, 0); PG8_STAGE(PG8_SA(0, 1), a2 + hstep, voffA);
            PG8_WAIT_L(8); PG8_BAR; PG8_WAIT_L(0); PG8_MMA(0, 0, At, B0); PG8_BAR; PG8_SCHED;
            PG8_LDB(B1, 1, 1); PG8_STAGE(PG8_SB(1, 0), b3, voffB);
            PG8_BAR; PG8_WAIT_L(0); PG8_MMA(0, 1, At, B1); PG8_BAR;
            PG8_LDA(At, 1, 1); PG8_STAGE(PG8_SA(1, 0), a3, voffA);
            PG8_BAR; PG8_WAIT_L(0); PG8_MMA(1, 0, At, B0); PG8_BAR; PG8_SCHED;
            PG8_STAGE(PG8_SB(1, 1), b3 + hstep, voffB);
            PG8_WAIT_V(6); PG8_BAR; PG8_MMA(1, 1, At, B1); PG8_BAR;
            }
        }
        if constexpr (ALIGN_EPI) { if (wr == 0) PG8_BAR; }
        if constexpr (!Epi::AFTER_DRAIN) { E(acc, cur, wr, wc, fr, fq); S.done(cur); }
        if (!has_next) break;
#pragma unroll
        for (int a = 0; a < 2; ++a)
#pragma unroll
            for (int b = 0; b < 2; ++b)
#pragma unroll
                for (int m = 0; m < 4; ++m)
#pragma unroll
                    for (int n = 0; n < 2; ++n) acc[a][b][m][n] = (f32x4){0.f, 0.f, 0.f, 0.f};
        cur = nxt; cA = nA; cB = nB; ++ui;
        if constexpr (ALIGN_EPI) { if (wr == 1) PG8_BAR; }
    }
    PG8_WAIT_V(0);
    if constexpr (!ALIGN_EPI) { if (wr == 0) PG8_BAR; }
    PG8_BAR;
    if constexpr (Epi::AFTER_DRAIN) { E.fused(acc, cur, wr, wc, fr, fq, lds, wid, lane); S.done(cur); }
#undef PG8_SA
#undef PG8_SB
#undef PG8_STAGE
#undef PG8_LDA
#undef PG8_LDB
#undef PG8_MMA
#undef PG8_WAIT_V
#undef PG8_WAIT_L
#undef PG8_BAR
#undef PG8_SCHED
}
}

#define LAS __attribute__((address_space(3)))
using pg8::bf16_t; using pg8::bf16x8; using pg8::f32x4; using pg8::u32x4; using pg8::Unit;
typedef float f32x16 __attribute__((ext_vector_type(16)));
typedef unsigned u32x2 __attribute__((ext_vector_type(2)));
constexpr int DM = 1024, NB = 16, SEQ = 2048, CTXL = 256, DEPTH = 4;
constexpr int RL = NB * SEQ, RC = NB * CTXL, RT = RL + RC;
constexpr int INW = 4608, DFF = 2816, NKEYS = CTXL + SEQ;
constexpr float QSCALE = 0.125f * 1.4426950408889634f;
constexpr float EPS = 1e-6f;
constexpr size_t MiB = (size_t)1 << 20;
constexpr size_t WS_ROPE = 65536, WS_LAM = 131072, WS_MOD = 1 * MiB, WS_SGW = 3 * MiB;
constexpr size_t WS_WIN = 4 * MiB, WS_WA = 13 * MiB, WS_WSG = 14 * MiB, WS_WO = 15 * MiB, WS_WF1 = 17 * MiB, WS_WF2 = 28 * MiB;
constexpr size_t WS_XC = 34 * MiB, WS_H = 50 * MiB;
constexpr size_t WS_K = 122 * MiB, WS_VT = 158 * MiB, WS_Q = 194 * MiB, WS_U = 230 * MiB, WS_SV = 266 * MiB, WS_G = 302 * MiB, WS_ACT = 122 * MiB;
constexpr size_t WS_O = DUP_ATTN ? 446 * MiB : WS_Q;
constexpr size_t WS_END = (DUP_ATTN ? 482 : 446) * MiB;
constexpr int LDS_BYTES = 147456;
constexpr int NPHASE = 2 + 8 * DEPTH;

struct Params { const float* in[23]; float* out; unsigned char* ws; float lam_init[4]; int lo, hi; };

__device__ __forceinline__ float bf2f(unsigned short b) { return __uint_as_float((unsigned)b << 16); }
__device__ __forceinline__ float bflo(unsigned w) { return __uint_as_float(w << 16); }
__device__ __forceinline__ float bfhi(unsigned w) { return __uint_as_float(w & 0xffff0000u); }
__device__ __forceinline__ unsigned pk2(float lo, float hi) { return pg8::cvt_pk_bf16(lo, hi); }
__device__ __forceinline__ float fast_exp2(float x) { return __builtin_amdgcn_exp2f(x); }
__device__ __forceinline__ float fast_rcp(float x) { return __builtin_amdgcn_rcpf(x); }
__device__ __forceinline__ float sigmoidf_(float x) { return fast_rcp(1.0f + fast_exp2(-1.4426950408889634f * x)); }
__device__ __forceinline__ float siluf_(float x) { return x * sigmoidf_(x); }
__device__ __forceinline__ float geluf_(float x) { const float u = x * (0.7978845608028654f + 0.035677408136300125f * x * x); return x * fast_rcp(1.0f + fast_exp2(-2.8853900817779268f * u)); }
__device__ __forceinline__ float wave_sum(float v) {
#pragma unroll
    for (int o = 1; o < 64; o <<= 1) v += __shfl_xor(v, o);
    return v;
}
#define LDS_WAIT() asm volatile("s_waitcnt lgkmcnt(0)" ::: "memory")

struct EpiG1 {
    static constexpr bool PERM = true, AFTER_DRAIN = false;
    bf16_t *Kb, *VT, *Qb, *Ub, *SVb, *Gb; const float* rope; int row_off;
    __device__ __forceinline__ void operator()(const f32x4 (&acc)[2][2][4][2], const Unit& u, int wr, int wc, int fr, int fq) const {
        const int rbase = row_off + u.pm * 256 + wr * 64 + fr;
        const bool latent = (row_off + u.pm * 256) < RL;
        const int pn = u.pn, cw = wc * 32 + 8 * fq;
        if (pn >= 6) {
            const bool gate = pn >= 10;
            bf16_t* base; int ld;
            if (gate) { base = Gb + (pn - 10) * 256 + cw; ld = 2048; } else { base = (pn < 8 ? Ub : SVb) + (pn & 1) * 256 + cw; ld = 512; }
#pragma unroll
            for (int ai = 0; ai < 2; ++ai)
#pragma unroll
                for (int m = 0; m < 4; ++m) { bf16_t* rowp = base + (size_t)(rbase + ai * 128 + m * 16) * ld;
#pragma unroll
                    for (int bj = 0; bj < 2; ++bj) { const f32x4 v0 = acc[ai][bj][m][0], v1 = acc[ai][bj][m][1]; float y[8];
#pragma unroll
                        for (int j = 0; j < 4; ++j) { y[j] = gate ? sigmoidf_(v0[j]) : geluf_(v0[j]); y[4 + j] = gate ? sigmoidf_(v1[j]) : geluf_(v1[j]); }
                        u32x4 w; w.x = pk2(y[0], y[1]); w.y = pk2(y[2], y[3]); w.z = pk2(y[4], y[5]); w.w = pk2(y[6], y[7]);
                        *(u32x4*)(rowp + bj * 128) = w; } }
        } else if (pn == 2 || pn == 3) {
#pragma unroll
            for (int ai = 0; ai < 2; ++ai)
#pragma unroll
                for (int m = 0; m < 4; ++m) { const int row = rbase + ai * 128 + m * 16; int b, key;
                    if (latent) { b = row >> 11; key = CTXL + (row & 2047); } else { const int rc = row - RL; b = rc >> 8; key = rc & 255; }
                    const int pos = (key & ~12) | ((key & 4) << 1) | ((key & 8) >> 1);
#pragma unroll
                    for (int bj = 0; bj < 2; ++bj) { const int head = (pn & 1) * 2 + bj; bf16_t* p = VT + ((size_t)((b * 4 + head) * 128 + cw)) * NKEYS + pos;
                        const f32x4 v0 = acc[ai][bj][m][0], v1 = acc[ai][bj][m][1];
                        const unsigned w0 = pk2(v0[0], v0[1]), w1 = pk2(v0[2], v0[3]), w2 = pk2(v1[0], v1[1]), w3 = pk2(v1[2], v1[3]);
                        p[0 * NKEYS] = (bf16_t)(w0 & 0xffff); p[1 * NKEYS] = (bf16_t)(w0 >> 16); p[2 * NKEYS] = (bf16_t)(w1 & 0xffff); p[3 * NKEYS] = (bf16_t)(w1 >> 16);
                        p[4 * NKEYS] = (bf16_t)(w2 & 0xffff); p[5 * NKEYS] = (bf16_t)(w2 >> 16); p[6 * NKEYS] = (bf16_t)(w3 & 0xffff); p[7 * NKEYS] = (bf16_t)(w3 >> 16); } }
        } else {
            const bool isq = pn >= 4; bf16_t* base = (isq ? Qb : Kb) + (pn & 1) * 256 + cw; const float sc = isq ? QSCALE : 1.0f;
#pragma unroll
            for (int ai = 0; ai < 2; ++ai)
#pragma unroll
                for (int m = 0; m < 4; ++m) { const int row = rbase + ai * 128 + m * 16;
                    f32x4 cs = (f32x4){1.f, 1.f, 1.f, 1.f}, sn = (f32x4){0.f, 0.f, 0.f, 0.f};
                    if (latent) { const int s = row & 2047, pos = (wc & 1) ? (s & 63) : (s >> 6); cs = *(const f32x4*)(rope + pos * 32 + 4 * fq); sn = *(const f32x4*)(rope + pos * 32 + 16 + 4 * fq); }
                    cs = cs * sc; sn = sn * sc;
#pragma unroll
                    for (int bj = 0; bj < 2; ++bj) { const f32x4 v0 = acc[ai][bj][m][0], v1 = acc[ai][bj][m][1]; u32x4 w;
                        w.x = pk2(v0[0] * cs[0] - v0[1] * sn[0], v0[1] * cs[0] + v0[0] * sn[0]);
                        w.y = pk2(v0[2] * cs[1] - v0[3] * sn[1], v0[3] * cs[1] + v0[2] * sn[1]);
                        w.z = pk2(v1[0] * cs[2] - v1[1] * sn[2], v1[1] * cs[2] + v1[0] * sn[2]);
                        w.w = pk2(v1[2] * cs[3] - v1[3] * sn[3], v1[3] * cs[3] + v1[2] * sn[3]);
                        *(u32x4*)(base + (size_t)row * 512 + bj * 128) = w; } }
        }
    }
};
template <int STEP> struct EpiMerge {
    static constexpr bool PERM = true, AFTER_DRAIN = false;
    const bf16_t* Gb; bf16_t* Mb;
    __device__ __forceinline__ void operator()(const f32x4 (&acc)[2][2][4][2], const Unit& u, int wr, int wc, int fr, int fq) const {
        const int rbase = u.pm * 256 + wr * 64 + fr, col0 = u.pn * 256 + wc * 32 + 8 * fq;
#pragma unroll
        for (int ai = 0; ai < 2; ++ai)
#pragma unroll
            for (int m = 0; m < 4; ++m) { const size_t row = (size_t)(rbase + ai * 128 + m * 16);
#pragma unroll
                for (int bj = 0; bj < 2; ++bj) { const f32x4 v0 = acc[ai][bj][m][0], v1 = acc[ai][bj][m][1];
                    const u32x4 g = *(const u32x4*)(Gb + row * 2048 + (STEP - 1) * 1024 + col0 + bj * 128);
                    bf16_t* mp = Mb + row * 1024 + col0 + bj * 128; float y[8];
                    y[0] = bflo(g.x) * v0[0]; y[1] = bfhi(g.x) * v0[1]; y[2] = bflo(g.y) * v0[2]; y[3] = bfhi(g.y) * v0[3];
                    y[4] = bflo(g.z) * v1[0]; y[5] = bfhi(g.z) * v1[1]; y[6] = bflo(g.w) * v1[2]; y[7] = bfhi(g.w) * v1[3];
                    if (STEP == 2) { const u32x4 t = *(const u32x4*)mp;
                        y[0] += bflo(t.x); y[1] += bfhi(t.x); y[2] += bflo(t.y); y[3] += bfhi(t.y); y[4] += bflo(t.z); y[5] += bfhi(t.z); y[6] += bflo(t.w); y[7] += bfhi(t.w); }
                    u32x4 w; w.x = pk2(y[0], y[1]); w.y = pk2(y[2], y[3]); w.z = pk2(y[4], y[5]); w.w = pk2(y[6], y[7]);
                    *(u32x4*)mp = w; } }
    }
};
struct EpiResid {
    static constexpr bool PERM = false, AFTER_DRAIN = false;
    const float* base_l; const float* base_c; float* out_l; float* out_c; const float* gate;
    __device__ __forceinline__ void operator()(const f32x4 (&acc)[2][2][4][2], const Unit& u, int wr, int wc, int fr, int fq) const {
        const int row0 = u.pm * 256; const bool latent = row0 < RL;
        const float* gp = gate + (size_t)(latent ? (row0 >> 11) : 16) * 6144;
        const float* bp = latent ? base_l + (size_t)row0 * DM : base_c + (size_t)(row0 - RL) * DM;
        float* op = latent ? out_l + (size_t)row0 * DM : out_c + (size_t)(row0 - RL) * DM;
        const int col0 = u.pn * 256 + wc * 32 + 4 * fq;
        f32x4 gv[2][2];
#pragma unroll
        for (int bj = 0; bj < 2; ++bj)
#pragma unroll
            for (int n = 0; n < 2; ++n) gv[bj][n] = *(const f32x4*)(gp + col0 + bj * 128 + n * 16);
#pragma unroll
        for (int ai = 0; ai < 2; ++ai)
#pragma unroll
            for (int m = 0; m < 4; ++m) { const size_t off = (size_t)(wr * 64 + fr + ai * 128 + m * 16) * DM + col0;
#pragma unroll
                for (int bj = 0; bj < 2; ++bj)
#pragma unroll
                    for (int n = 0; n < 2; ++n) { const f32x4 b = *(const f32x4*)(bp + off + bj * 128 + n * 16); *(f32x4*)(op + off + bj * 128 + n * 16) = b + gv[bj][n] * acc[ai][bj][m][n]; } }
    }
};
struct EpiFfn1 {
    static constexpr bool PERM = true, AFTER_DRAIN = false;
    bf16_t* act;
    __device__ __forceinline__ void operator()(const f32x4 (&acc)[2][2][4][2], const Unit& u, int wr, int wc, int fr, int fq) const {
        const int rbase = u.pm * 256 + wr * 64 + fr, col0 = u.pn * 128 + wc * 32 + 8 * fq;
#pragma unroll
        for (int ai = 0; ai < 2; ++ai)
#pragma unroll
            for (int m = 0; m < 4; ++m) { const f32x4 a0 = acc[ai][0][m][0], a1 = acc[ai][0][m][1], b0 = acc[ai][1][m][0], b1 = acc[ai][1][m][1]; float y[8];
#pragma unroll
                for (int j = 0; j < 4; ++j) { y[j] = siluf_(a0[j]) * b0[j]; y[4 + j] = siluf_(a1[j]) * b1[j]; }
                u32x4 w; w.x = pk2(y[0], y[1]); w.y = pk2(y[2], y[3]); w.z = pk2(y[4], y[5]); w.w = pk2(y[6], y[7]);
                *(u32x4*)(act + (size_t)(rbase + ai * 128 + m * 16) * DFF + col0) = w; }
    }
};

template <int MODE> __device__ __forceinline__ void transpose_item(const float* W, int K, int N, bf16_t* WT, LAS float* scr, int item, int lane) {
    const int nblk = N / 32, kb = item / nblk, nb = item % nblk, k0 = 64 * kb, n0 = 32 * nb, i = lane & 31;
    int srccol;
    if (MODE == 1) { const bool qk = (n0 < 512) || (n0 >= 1024 && n0 < 1536); srccol = n0 + (qk ? ((i & 1) * 16 + (i >> 1)) : i); }
    else if (MODE == 2) { const int pn = nb >> 3, half = (nb >> 2) & 1, jb = nb & 3; srccol = half * DFF + 128 * pn + 32 * jb + i; }
    else srccol = n0 + i;
#pragma unroll 8
    for (int t = 0; t < 32; ++t) { const int kk = 2 * t + (lane >> 5); scr[kk * 33 + i] = W[(size_t)(k0 + kk) * N + srccol]; }
    LDS_WAIT();
    const int c = lane & 7;
#pragma unroll
    for (int j = 0; j < 4; ++j) { const int n = (lane >> 3) + 8 * j; const LAS float* s = scr + (8 * c) * 33 + n;
        u32x4 o; o.x = pk2(s[0 * 33], s[1 * 33]); o.y = pk2(s[2 * 33], s[3 * 33]); o.z = pk2(s[4 * 33], s[5 * 33]); o.w = pk2(s[6 * 33], s[7 * 33]);
        *(u32x4*)(WT + (size_t)(n0 + n) * K + k0 + 8 * c) = o; }
    LDS_WAIT();
}
__device__ __forceinline__ void convert_layer_weights(const Params& p, int layer, LAS unsigned char* lds, int wid, int lane) {
    LAS float* scr = (LAS float*)(lds + wid * 8448);
    const int gw = blockIdx.x * 8 + wid, NGW = gridDim.x * 8;
    unsigned char* ws = p.ws;
    const float* w_in = p.in[7] + (size_t)layer * DM * INW; const float* w_a = p.in[16] + (size_t)layer * 512 * DM; const float* w_sg = p.in[17] + (size_t)layer * 512 * DM;
    const float* w_o = p.in[18] + (size_t)layer * DM * DM; const float* w_f1 = p.in[20] + (size_t)layer * DM * 2 * DFF; const float* w_f2 = p.in[21] + (size_t)layer * DFF * DM;
    constexpr int I_IN = 16 * 144, I_A = 8 * 32, I_O = 16 * 32, I_F1 = 16 * 176, I_F2 = 44 * 32, NIT = I_IN + 2 * I_A + I_O + I_F1 + I_F2;
    for (int it = gw; it < NIT; it += NGW) {
        int r = it;
        if (r < I_IN) { transpose_item<1>(w_in, DM, INW, (bf16_t*)(ws + WS_WIN), scr, r, lane); continue; } r -= I_IN;
        if (r < I_A) { transpose_item<0>(w_a, 512, DM, (bf16_t*)(ws + WS_WA), scr, r, lane); continue; } r -= I_A;
        if (r < I_A) { transpose_item<0>(w_sg, 512, DM, (bf16_t*)(ws + WS_WSG), scr, r, lane); continue; } r -= I_A;
        if (r < I_O) { transpose_item<0>(w_o, DM, DM, (bf16_t*)(ws + WS_WO), scr, r, lane); continue; } r -= I_O;
        if (r < I_F1) { transpose_item<2>(w_f1, DM, 2 * DFF, (bf16_t*)(ws + WS_WF1), scr, r, lane); continue; } r -= I_F1;
        transpose_item<0>(w_f2, DFF, DM, (bf16_t*)(ws + WS_WF2), scr, r, lane);
    }
}
__device__ __forceinline__ void norm_row(const float* xrow, bf16_t* hrow, const float* g, const float* sh, const float* sc, int lane) {
    f32x4 v[4]; float ss = 0.f;
#pragma unroll
    for (int j = 0; j < 4; ++j) { v[j] = ((const f32x4*)xrow)[lane + 64 * j]; ss += (v[j].x * v[j].x + v[j].y * v[j].y) + (v[j].z * v[j].z + v[j].w * v[j].w); }
    const float rstd = 1.0f / sqrtf(wave_sum(ss) * (1.0f / DM) + EPS);
#pragma unroll
    for (int j = 0; j < 4; ++j) { const f32x4 gg = ((const f32x4*)g)[lane + 64 * j], s1 = ((const f32x4*)sc)[lane + 64 * j], s0 = ((const f32x4*)sh)[lane + 64 * j];
        const f32x4 y = (v[j] * rstd) * gg * (s1 + 1.0f) + s0;
        u32x2 w; w.x = pk2(y.x, y.y); w.y = pk2(y.z, y.w); ((u32x2*)hrow)[lane + 64 * j] = w; }
}
__device__ __forceinline__ void norm_phase(const Params& p, int layer, int which  , int nrows, int wid, int lane) {
    const float* xl = (layer == 0 && which == 0) ? p.in[0] : p.out;
    const float* xc = (layer == 0 && which == 0) ? p.in[2] : (const float*)(p.ws + WS_XC);
    const float* g = (which == 0 ? p.in[6] : p.in[19]) + layer * DM;
    const float* mod = (const float*)(p.ws + WS_MOD) + (size_t)layer * 17 * 6144 + (which == 0 ? 0 : 3) * DM;
    bf16_t* H = (bf16_t*)(p.ws + WS_H);
    const int gw = blockIdx.x * 8 + wid, NGW = gridDim.x * 8;
    for (int r = gw; r < nrows; r += NGW) {
        const bool latent = r < RL; const int vec = latent ? (r >> 11) : 16;
        const float* xr = latent ? xl + (size_t)r * DM : xc + (size_t)(r - RL) * DM;
        norm_row(xr, H + (size_t)r * DM, g, mod + (size_t)vec * 6144, mod + (size_t)vec * 6144 + DM, lane);
    }
}
__device__ __forceinline__ void prologue_phase(const Params& p, LAS unsigned char* lds, int tid, int wid, int lane) {
    LAS float* sct = (LAS float*)lds;
    LAS float* red = (LAS float*)(lds + 81920);
    const float* c = p.in[1]; const float* cctx = p.in[3];
    for (int idx = tid; idx < 17 * 1024; idx += 512) { const int v = idx >> 10, k = idx & 1023; const float cv = (v < 16) ? c[v * 1024 + k] : cctx[k]; sct[k * 20 + v] = cv / (1.0f + expf(-cv)); }
    __syncthreads();
    float* mod = (float*)(p.ws + WS_MOD);
    for (int it = blockIdx.x; it < 4 * 96; it += gridDim.x) {
        const int layer = it / 96, nb = it % 96;
        const float* W = p.in[4] + (size_t)layer * DM * 6144 + nb * 64 + lane;
        float acc[17];
#pragma unroll
        for (int v = 0; v < 17; ++v) acc[v] = 0.f;
#pragma unroll 4
        for (int kk = 0; kk < 128; ++kk) { const int k = wid * 128 + kk; const float w = W[(size_t)k * 6144];
            const LAS f32x4* s4 = (const LAS f32x4*)(sct + k * 20);
            const f32x4 a = s4[0], b = s4[1], cc = s4[2], d = s4[3], e = s4[4];
            acc[0] += w * a.x; acc[1] += w * a.y; acc[2] += w * a.z; acc[3] += w * a.w; acc[4] += w * b.x; acc[5] += w * b.y; acc[6] += w * b.z; acc[7] += w * b.w;
            acc[8] += w * cc.x; acc[9] += w * cc.y; acc[10] += w * cc.z; acc[11] += w * cc.w; acc[12] += w * d.x; acc[13] += w * d.y; acc[14] += w * d.z; acc[15] += w * d.w; acc[16] += w * e.x; }
#pragma unroll
        for (int v = 0; v < 17; ++v) red[(wid * 17 + v) * 64 + lane] = acc[v];
        __syncthreads();
        for (int o = tid; o < 17 * 64; o += 512) { const int v = o >> 6, l = o & 63; float s = 0.f;
#pragma unroll
            for (int w = 0; w < 8; ++w) s += red[(w * 17 + v) * 64 + l];
            mod[((size_t)layer * 17 + v) * 6144 + nb * 64 + l] = s + p.in[5][layer * 6144 + nb * 64 + l]; }
        __syncthreads();
    }
    if (blockIdx.x == 0) {
        float* rope = (float*)(p.ws + WS_ROPE);
        for (int t = tid; t < 1024; t += 512) { const int pos = t >> 4, m = t & 15;
            double pw = 1.0; for (int i = 0; i < (m >> 2); ++i) pw *= 10.0;
            pw *= (m & 3) == 0 ? 1.0 : (m & 3) == 1 ? 1.7782794100389228 : (m & 3) == 2 ? 3.1622776601683795 : 5.623413251903491;
            const float inv = 1.0f / (float)pw; const float angf = (float)pos * inv;
            double a = (double)angf; const double twopi = 6.283185307179586476925286766559; a -= twopi * rint(a / twopi);
            double sn = 0.0, cs = 0.0, term = 1.0;
            for (int n = 0; n < 30; n += 2) { cs += ((n & 2) ? -term : term); term *= a / (double)(n + 1); sn += ((n & 2) ? -term : term); term *= a / (double)(n + 2); }
            rope[pos * 32 + m] = (float)cs; rope[pos * 32 + 16 + m] = (float)sn; }
    }
    if (blockIdx.x == 1 && wid < 4) {
        const float a = p.in[8][wid * 64 + lane] * p.in[9][wid * 64 + lane], b = p.in[10][wid * 64 + lane] * p.in[11][wid * 64 + lane];
        const float sa = wave_sum(a), sb = wave_sum(b);
        if (lane == 0) ((float*)(p.ws + WS_LAM))[wid] = expf(sa) - expf(sb) + ((const LAS float*)(lds + 143360 + 200))[wid];
    }
    { bf16_t* sgw = (bf16_t*)(p.ws + WS_SGW); const float* src = p.in[14];
      for (int i = blockIdx.x * 512 + tid; i < 4 * 4 * 128 * 128 / 2; i += gridDim.x * 512) ((unsigned*)sgw)[i] = pk2(src[2 * i], src[2 * i + 1]); }
}

struct AttnArgs { const bf16_t* Q; const bf16_t* K; const bf16_t* VT; bf16_t* O; const float* subln; float lam, oscale; };
constexpr int AKB = 64 * 272, AVB = 128 * 144;
__device__ __forceinline__ void attn_unit(LAS unsigned char* lds, const AttnArgs& a, int b, int h, int qrow0, int ntiles, int tid, int wid, int lane) {
    const int qb = wid >> 1, mp = wid & 1, r32 = lane & 31, hi = lane >> 5;
    const int kch = tid & 15, krow = tid >> 4, vch = tid & 7, vrow = tid >> 3;
    const bf16_t* kctx = a.K + (size_t)(RL + b * CTXL + krow) * 512 + h * 128 + kch * 8;
    const bf16_t* klat = a.K + (size_t)(b * SEQ + krow) * 512 + h * 128 + kch * 8;
    const bf16_t* vsrc = a.VT + ((size_t)((b * 4 + h) * 128 + vrow)) * NKEYS + vch * 8;
    u32x4 kr0, kr1, vr0, vr1;
#define ATT_LOADK(j) do { const bf16_t* kp_ = ((j) < 4) ? kctx + (size_t)(64 * (j)) * 512 : klat + (size_t)(64 * ((j) - 4)) * 512; kr0 = *(const u32x4*)kp_; kr1 = *(const u32x4*)(kp_ + 32 * 512); } while (0)
#define ATT_LOADV(j) do { vr0 = *(const u32x4*)(vsrc + 64 * (j)); vr1 = *(const u32x4*)(vsrc + (size_t)64 * NKEYS + 64 * (j)); } while (0)
#define ATT_STOREK(j) do { *(LAS u32x4*)(lds + ((j) & 1) * AKB + krow * 272 + kch * 16) = kr0; *(LAS u32x4*)(lds + ((j) & 1) * AKB + (krow + 32) * 272 + kch * 16) = kr1; } while (0)
#define ATT_STOREV(j) do { *(LAS u32x4*)(lds + 2 * AKB + ((j) & 1) * AVB + vrow * 144 + vch * 16) = vr0; *(LAS u32x4*)(lds + 2 * AKB + ((j) & 1) * AVB + (vrow + 64) * 144 + vch * 16) = vr1; } while (0)
    bf16x8 qf[4];
    { const bf16_t* qp = a.Q + (size_t)(qrow0 + qb * 32 + r32) * 512 + h * 128 + mp * 64 + hi * 8;
#pragma unroll
      for (int ks = 0; ks < 4; ++ks) qf[ks] = *(const bf16x8*)(qp + ks * 16); }
    ATT_LOADK(0); ATT_STOREK(0);
    __syncthreads();
    f32x16 o[4];
#pragma unroll
    for (int d = 0; d < 4; ++d)
#pragma unroll
        for (int r = 0; r < 16; ++r) o[d][r] = 0.f;
    float mref = 0.f, lsum = 0.f, alpha_pend = 1.f; bool pend = false; f32x16 negm, s0, s1; bf16x8 pf[4];
#pragma unroll
    for (int r = 0; r < 16; ++r) negm[r] = 0.f;
    constexpr float THR = 8.0f;
#define ATT_QK(t) do { const LAS unsigned char* Kp = lds + ((t) & 1) * AKB + r32 * 272 + (mp * 64 + hi * 8) * 2; \
        _Pragma("unroll") for (int ks = 0; ks < 4; ++ks) { \
            const bf16x8 k0 = *(const LAS bf16x8*)(Kp + ks * 32), k1 = *(const LAS bf16x8*)(Kp + 32 * 272 + ks * 32); \
            if (ks == 0) { s0 = __builtin_amdgcn_mfma_f32_32x32x16_bf16(k0, qf[0], negm, 0, 0, 0); s1 = __builtin_amdgcn_mfma_f32_32x32x16_bf16(k1, qf[0], negm, 0, 0, 0); } \
            else { s0 = __builtin_amdgcn_mfma_f32_32x32x16_bf16(k0, qf[ks], s0, 0, 0, 0); s1 = __builtin_amdgcn_mfma_f32_32x32x16_bf16(k1, qf[ks], s1, 0, 0, 0); } } } while (0)
#define ATT_CHECK(first) do { float mx = __builtin_fmaxf(__builtin_fmaxf(s0[0], s1[0]), s0[1]); \
        _Pragma("unroll") for (int r = 2; r < 16; r += 2) mx = __builtin_fmaxf(__builtin_fmaxf(mx, s0[r]), s0[r + 1]); \
        _Pragma("unroll") for (int r = 1; r < 16; r += 2) mx = __builtin_fmaxf(__builtin_fmaxf(mx, s1[r]), s1[(r + 1) & 15]); \
        pend = false; \
        if ((first) || __any(mx > THR)) { mx = fmaxf(mx, __shfl_xor(mx, 32)); \
            const float delta = (first) ? mx : fmaxf(mx, 0.f); alpha_pend = fast_exp2(-delta); mref += delta; lsum *= alpha_pend; pend = !(first); \
            _Pragma("unroll") for (int r = 0; r < 16; ++r) { negm[r] = -mref; s0[r] -= delta; s1[r] -= delta; } } } while (0)
#define ATT_EXPSUM() do { float ps = 0.f; _Pragma("unroll") for (int r = 0; r < 16; ++r) { s0[r] = fast_exp2(s0[r]); s1[r] = fast_exp2(s1[r]); ps += s0[r] + s1[r]; } lsum += ps; } while (0)
#define ATT_PACK() do { u32x4 w; \
        w.x = pk2(s0[0], s0[1]); w.y = pk2(s0[2], s0[3]); w.z = pk2(s0[4], s0[5]); w.w = pk2(s0[6], s0[7]); pf[0] = __builtin_bit_cast(bf16x8, w); \
        w.x = pk2(s0[8], s0[9]); w.y = pk2(s0[10], s0[11]); w.z = pk2(s0[12], s0[13]); w.w = pk2(s0[14], s0[15]); pf[1] = __builtin_bit_cast(bf16x8, w); \
        w.x = pk2(s1[0], s1[1]); w.y = pk2(s1[2], s1[3]); w.z = pk2(s1[4], s1[5]); w.w = pk2(s1[6], s1[7]); pf[2] = __builtin_bit_cast(bf16x8, w); \
        w.x = pk2(s1[8], s1[9]); w.y = pk2(s1[10], s1[11]); w.z = pk2(s1[12], s1[13]); w.w = pk2(s1[14], s1[15]); pf[3] = __builtin_bit_cast(bf16x8, w); } while (0)
#define ATT_PV(t) do { const LAS unsigned char* Vp = lds + 2 * AKB + ((t) & 1) * AVB + r32 * 144 + hi * 16; \
        _Pragma("unroll") for (int s4 = 0; s4 < 4; ++s4) _Pragma("unroll") for (int d = 0; d < 4; ++d) { \
            const bf16x8 vf = *(const LAS bf16x8*)(Vp + d * 32 * 144 + s4 * 32); o[d] = __builtin_amdgcn_mfma_f32_32x32x16_bf16(vf, pf[s4], o[d], 0, 0, 0); } } while (0)
#define ATT_RESC() do { if (pend) { _Pragma("unroll") for (int d = 0; d < 4; ++d) _Pragma("unroll") for (int r = 0; r < 16; ++r) o[d][r] *= alpha_pend; } } while (0)
    ATT_LOADK(1); ATT_LOADV(0);
    ATT_QK(0); ATT_CHECK(true); ATT_EXPSUM(); ATT_PACK();
    ATT_STOREK(1); ATT_STOREV(0);
    __syncthreads();
    for (int t = 1; t < ntiles; ++t) {
        if (t + 1 < ntiles) ATT_LOADK(t + 1);
        ATT_LOADV(t);
        ATT_QK(t);
        ATT_CHECK(false);
        __builtin_amdgcn_sched_barrier(0);
        { bf16x8 pfo[4] = {pf[0], pf[1], pf[2], pf[3]};
          const LAS unsigned char* Vp = lds + 2 * AKB + ((t - 1) & 1) * AVB + r32 * 144 + hi * 16;
          float ps = 0.f;
#pragma unroll
          for (int s4 = 0; s4 < 4; ++s4) {
#pragma unroll
              for (int d = 0; d < 4; ++d) { const bf16x8 vf = *(const LAS bf16x8*)(Vp + d * 32 * 144 + s4 * 32); o[d] = __builtin_amdgcn_mfma_f32_32x32x16_bf16(vf, pfo[s4], o[d], 0, 0, 0); }
              if (s4 < 2) {
#pragma unroll
                  for (int r = 8 * s4; r < 8 * s4 + 8; ++r) { s0[r] = fast_exp2(s0[r]); ps += s0[r]; }
              } else {
#pragma unroll
                  for (int r = 8 * (s4 - 2); r < 8 * (s4 - 2) + 8; ++r) { s1[r] = fast_exp2(s1[r]); ps += s1[r]; }
              }
          }
          lsum += ps;
          asm volatile("" : "+v"(s0), "+v"(s1), "+v"(lsum));
          __builtin_amdgcn_sched_group_barrier(0x100, 2, 0);
#pragma unroll
          for (int i = 0; i < 16; ++i) { __builtin_amdgcn_sched_group_barrier(0x008, 1, 0); __builtin_amdgcn_sched_group_barrier(0x100, 1, 0); __builtin_amdgcn_sched_group_barrier(0x002, 4, 0); }
        }
        __builtin_amdgcn_sched_barrier(0);
        ATT_RESC();
        ATT_PACK();
        if (t + 1 < ntiles) ATT_STOREK(t + 1);
        ATT_STOREV(t);
        __syncthreads();
    }
    ATT_PV(ntiles - 1);
    __syncthreads();
#undef ATT_QK
#undef ATT_CHECK
#undef ATT_EXPSUM
#undef ATT_PACK
#undef ATT_PV
#undef ATT_RESC
#undef ATT_LOADK
#undef ATT_LOADV
#undef ATT_STOREK
#undef ATT_STOREV
    const float ltot = lsum + __shfl_xor(lsum, 32), inv = 1.0f / ltot;
    LAS float* X = (LAS float*)lds;
    if (mp == 1) {
#pragma unroll
        for (int d = 0; d < 4; ++d)
#pragma unroll
            for (int r = 0; r < 16; ++r) X[(qb * 64 + d * 16 + r) * 64 + lane] = o[d][r] * inv;
    }
    __syncthreads();
    if (mp == 0) {
        float ss = 0.f;
#pragma unroll
        for (int d = 0; d < 4; ++d)
#pragma unroll
            for (int r = 0; r < 16; ++r) { const float v = o[d][r] * inv - a.lam * X[(qb * 64 + d * 16 + r) * 64 + lane]; o[d][r] = v; ss += v * v; }
        ss += __shfl_xor(ss, 32);
        const float rn = a.oscale / sqrtf(ss * (1.0f / 128.0f) + EPS);
        bf16_t* op = a.O + (size_t)(qrow0 + qb * 32 + r32) * 512 + h * 128 + 4 * hi;
#pragma unroll
        for (int d = 0; d < 4; ++d)
#pragma unroll
            for (int g4 = 0; g4 < 4; ++g4) { const f32x4 gv = *(const f32x4*)(a.subln + d * 32 + 8 * g4 + 4 * hi);
                u32x2 w; w.x = pk2(o[d][4 * g4] * rn * gv.x, o[d][4 * g4 + 1] * rn * gv.y); w.y = pk2(o[d][4 * g4 + 2] * rn * gv.z, o[d][4 * g4 + 3] * rn * gv.w);
                *(u32x2*)(op + d * 32 + 8 * g4) = w; }
    }
    __syncthreads();
}
__device__ __forceinline__ void sg_unit(LAS unsigned char* lds, int R0, const bf16_t* SV, bf16_t* U, const float* ng, const bf16_t* sgw, const float* sgb, int tid, int wid, int lane) {
    LAS float* st = (LAS float*)(lds + 139264);
    for (int i = 0; i < 16; ++i) { const int row = wid * 16 + i;
        const u32x4 x = *(const u32x4*)(SV + (size_t)(R0 + row) * 512 + lane * 8);
        const float f0 = bflo(x.x), f1 = bfhi(x.x), f2 = bflo(x.y), f3 = bfhi(x.y), f4 = bflo(x.z), f5 = bfhi(x.z), f6 = bflo(x.w), f7 = bfhi(x.w);
        const float mean = wave_sum(((f0 + f1) + (f2 + f3)) + ((f4 + f5) + (f6 + f7))) * (1.0f / 512.0f);
        const float d0 = f0 - mean, d1 = f1 - mean, d2 = f2 - mean, d3 = f3 - mean, d4 = f4 - mean, d5 = f5 - mean, d6 = f6 - mean, d7 = f7 - mean;
        const float var = wave_sum(((d0 * d0 + d1 * d1) + (d2 * d2 + d3 * d3)) + ((d4 * d4 + d5 * d5) + (d6 * d6 + d7 * d7))) * (1.0f / 512.0f);
        if (lane == 0) { st[row * 2] = mean; st[row * 2 + 1] = 1.0f / sqrtf(var + EPS); } }
    __syncthreads();
    { const f32x4 sv = *(const LAS f32x4*)(st + lane * 4);
      for (int t = 0; t < 8; ++t) { const int cb = wid * 8 + t;
        const u32x4 x0 = *(const u32x4*)(SV + (size_t)(R0 + 2 * lane) * 512 + cb * 8), x1 = *(const u32x4*)(SV + (size_t)(R0 + 2 * lane + 1) * 512 + cb * 8);
        const f32x4 g0 = *(const f32x4*)(ng + cb * 8), g1 = *(const f32x4*)(ng + cb * 8 + 4);
        LAS unsigned char* wp = lds + (cb * 8) * 272 + lane * 4;
        *(LAS unsigned*)(wp + 0 * 272) = pk2((bflo(x0.x) - sv.x) * sv.y * g0.x, (bflo(x1.x) - sv.z) * sv.w * g0.x);
        *(LAS unsigned*)(wp + 1 * 272) = pk2((bfhi(x0.x) - sv.x) * sv.y * g0.y, (bfhi(x1.x) - sv.z) * sv.w * g0.y);
        *(LAS unsigned*)(wp + 2 * 272) = pk2((bflo(x0.y) - sv.x) * sv.y * g0.z, (bflo(x1.y) - sv.z) * sv.w * g0.z);
        *(LAS unsigned*)(wp + 3 * 272) = pk2((bfhi(x0.y) - sv.x) * sv.y * g0.w, (bfhi(x1.y) - sv.z) * sv.w * g0.w);
        *(LAS unsigned*)(wp + 4 * 272) = pk2((bflo(x0.z) - sv.x) * sv.y * g1.x, (bflo(x1.z) - sv.z) * sv.w * g1.x);
        *(LAS unsigned*)(wp + 5 * 272) = pk2((bfhi(x0.z) - sv.x) * sv.y * g1.y, (bfhi(x1.z) - sv.z) * sv.w * g1.y);
        *(LAS unsigned*)(wp + 6 * 272) = pk2((bflo(x0.w) - sv.x) * sv.y * g1.z, (bflo(x1.w) - sv.z) * sv.w * g1.z);
        *(LAS unsigned*)(wp + 7 * 272) = pk2((bfhi(x0.w) - sv.x) * sv.y * g1.w, (bfhi(x1.w) - sv.z) * sv.w * g1.w); } }
    __syncthreads();
    { const int g = wid >> 1, ph = wid & 1, r32 = lane & 31, hi = lane >> 5;
      for (int pbi = 0; pbi < 2; ++pbi) { const int pcol = (ph * 2 + pbi) * 32 + r32;
        f32x16 acc[4];
#pragma unroll
        for (int d = 0; d < 4; ++d)
#pragma unroll
            for (int r = 0; r < 16; ++r) acc[d][r] = 0.f;
        const bf16_t* wrow = sgw + ((size_t)g * 128 + pcol) * 128 + hi * 8;
        const LAS unsigned char* ap = lds + (g * 128 + r32) * 272 + hi * 16;
#pragma unroll
        for (int ks = 0; ks < 8; ++ks) { const bf16x8 bf = *(const bf16x8*)(wrow + ks * 16);
#pragma unroll
            for (int d = 0; d < 4; ++d) { const bf16x8 af = *(const LAS bf16x8*)(ap + d * 32 * 272 + ks * 32); acc[d] = __builtin_amdgcn_mfma_f32_32x32x16_bf16(af, bf, acc[d], 0, 0, 0); } }
        const float bias = sgb[g * 128 + pcol];
        bf16_t* up = U + (size_t)(R0 + pcol) * 512 + g * 128 + 4 * hi;
#pragma unroll
        for (int d = 0; d < 4; ++d)
#pragma unroll
            for (int g4 = 0; g4 < 4; ++g4) { const u32x2 uu = *(const u32x2*)(up + d * 32 + 8 * g4);
                u32x2 w; w.x = pk2(bflo(uu.x) * (acc[d][4 * g4] + bias), bfhi(uu.x) * (acc[d][4 * g4 + 1] + bias)); w.y = pk2(bflo(uu.y) * (acc[d][4 * g4 + 2] + bias), bfhi(uu.y) * (acc[d][4 * g4 + 3] + bias));
                *(u32x2*)(up + d * 32 + 8 * g4) = w; } } }
    __syncthreads();
}
__device__ __forceinline__ void mixer_phase(const Params& p, int layer, bool last, LAS unsigned char* lds, int tid, int wid, int lane) {
    AttnArgs a; a.Q = (const bf16_t*)(p.ws + WS_Q); a.K = (const bf16_t*)(p.ws + WS_K); a.VT = (const bf16_t*)(p.ws + WS_VT); a.O = (bf16_t*)(p.ws + WS_O);
    a.subln = p.in[12] + layer * 128; a.lam = ((const float*)(p.ws + WS_LAM))[layer]; a.oscale = 1.0f - ((const LAS float*)(lds + 143360 + 200))[layer];
    const int n_ctx_att = last ? 0 : 128, n_sg = last ? 256 : 288, n_items = 1024 + n_ctx_att + n_sg, G = gridDim.x;
    for (int rep = 0; rep < (DUP_ATTN ? 2 : 1); ++rep)
    for (int it = blockIdx.x; it < (rep == 0 ? n_items : 1024); it += G) {
        if (it < 1024) {
            int bh, qblk;
            if (G == 256) { const int c = it & 255, round = it >> 8, x = c & 7, slot = c >> 3; bh = round * 16 + x * 2 + (slot >> 4); qblk = slot & 15; } else { bh = it >> 4; qblk = it & 15; }
            attn_unit(lds, a, bh >> 2, bh & 3, (bh >> 2) * SEQ + qblk * 128, 36, tid, wid, lane);
        } else if (it < 1024 + n_ctx_att) { const int r = it - 1024, bh = r >> 1, half = r & 1;
            attn_unit(lds, a, bh >> 2, bh & 3, RL + (bh >> 2) * CTXL + half * 128, 4, tid, wid, lane);
        } else { const int n = it - 1024 - n_ctx_att;
            sg_unit(lds, n * 128, (const bf16_t*)(p.ws + WS_SV), (bf16_t*)(p.ws + WS_U), p.in[13] + layer * 512, (const bf16_t*)(p.ws + WS_SGW) + (size_t)layer * 4 * 128 * 128, p.in[15] + layer * 512, tid, wid, lane);
        }
    }
}
__device__ __forceinline__ void final_phase(const Params& p, int wid, int lane) {
    const float* g = p.in[22]; const int gw = blockIdx.x * 8 + wid, NGW = gridDim.x * 8;
    for (int r = gw; r < RL; r += NGW) { float* xr = p.out + (size_t)r * DM;
        f32x4 v[4]; float ss = 0.f;
#pragma unroll
        for (int j = 0; j < 4; ++j) { v[j] = ((const f32x4*)xr)[lane + 64 * j]; ss += (v[j].x * v[j].x + v[j].y * v[j].y) + (v[j].z * v[j].z + v[j].w * v[j].w); }
        const float rstd = 1.0f / sqrtf(wave_sum(ss) * (1.0f / DM) + EPS);
#pragma unroll
        for (int j = 0; j < 4; ++j) ((f32x4*)xr)[lane + 64 * j] = (v[j] * rstd) * ((const f32x4*)g)[lane + 64 * j]; }
}

typedef unsigned gu32_unused_t;
#define RLX_AGENT __ATOMIC_RELAXED, __HIP_MEMORY_SCOPE_AGENT
#define XB_TMO      128
#define XB_XCNT(j)  (256  + 64 * (j))
#define XB_XSUB(j)  (1280 + 64 * (j))
#define XB_XGEN(j)  (2304 + 64 * (j))
#define XB_TOP      3328
#define XB_TOPGEN   3392
#define XCD_BAR_WORDS 3456
#define XB_SPIN_CAP (1u << 18)

__device__ __forceinline__ unsigned xb_ld(unsigned* p)              { return __hip_atomic_load(p, __ATOMIC_RELAXED, __HIP_MEMORY_SCOPE_AGENT); }
__device__ __forceinline__ unsigned xb_add(unsigned* p, unsigned v) { return __hip_atomic_fetch_add(p, v, __ATOMIC_RELAXED, __HIP_MEMORY_SCOPE_AGENT); }
__device__ __forceinline__ unsigned xb_xcc_id() { return (unsigned)__builtin_amdgcn_s_getreg((3 << 11) | 20) & 0xFu; }
#define XB_SPIN(cond, bar) do { unsigned _sp = 0; while (cond) { __builtin_amdgcn_s_sleep(1); \
    if ((++_sp & 255u) == 0u) { if (xb_ld(&(bar)[XB_TMO])) break; if (_sp > XB_SPIN_CAP) { atomicAdd(&(bar)[XB_TMO], 1u); break; } } } } while (0)
struct XcdBarrier {
    unsigned* bar; unsigned x;
    volatile LAS unsigned* st;
};

__device__ __forceinline__ XcdBarrier xcd_barrier_post(unsigned* bar, volatile LAS unsigned* st) {
    XcdBarrier b; b.bar = bar; b.x = xb_xcc_id(); b.st = st;
    if (threadIdx.x == 0) (void)xb_add(&bar[XB_XCNT(b.x)], 1u);
    return b;
}
__device__ __forceinline__ void xcd_barrier_complete(unsigned* bar, unsigned x, unsigned& nloc, unsigned& nx) {
    const unsigned G = gridDim.x * gridDim.y * gridDim.z;
    unsigned sum, cnt, mine, sp = 0u;
    for (;;) {
        sum = 0u; cnt = 0u; mine = 0u;
#pragma unroll
        for (unsigned j = 0; j < 16; ++j) { const unsigned c = xb_ld(&bar[XB_XCNT(j)]); sum += c; cnt += (c > 0u) ? 1u : 0u; mine = (j == x) ? c : mine; }
        if (sum == G) break;
        __builtin_amdgcn_s_sleep(1);
        if ((++sp & 255u) == 0u) { if (xb_ld(&bar[XB_TMO])) break; if (sp > XB_SPIN_CAP) { atomicAdd(&bar[XB_TMO], 1u); break; } }
    }
    nloc = mine > 0u ? mine : 1u; nx = cnt > 0u ? cnt : 1u;
}

__device__ __forceinline__ void xcd_barrier(const XcdBarrier& b) {
    asm volatile("s_waitcnt vmcnt(0)" ::: "memory");
    __syncthreads();
    if (threadIdx.x == 0) {
        unsigned* bar = b.bar;
        __builtin_amdgcn_s_waitcnt(0);
        unsigned nloc = b.st[0], nx = b.st[1];
        if (nloc == 0u) { xcd_barrier_complete(bar, b.x, nloc, nx); b.st[0] = nloc; b.st[1] = nx; }
        const unsigned old = xb_add(&bar[XB_XSUB(b.x)], 1u);
        const unsigned gen = old / nloc;
        if (old + 1u == (gen + 1u) * nloc) {
            __builtin_amdgcn_fence(__ATOMIC_RELEASE, "agent");
            asm volatile("s_waitcnt vmcnt(0)" ::: "memory");
            const unsigned og = xb_add(&bar[XB_TOP], 1u);
            const unsigned tg = og / nx;
            if (og + 1u == (tg + 1u) * nx) xb_add(&bar[XB_TOPGEN], 1u);
            else XB_SPIN(xb_ld(&bar[XB_TOPGEN]) == tg, bar);
            __builtin_amdgcn_fence(__ATOMIC_ACQUIRE, "agent");
            xb_add(&bar[XB_XGEN(b.x)], 1u);
            asm volatile("s_waitcnt vmcnt(0)" ::: "memory");
        } else {
            XB_SPIN(xb_ld(&bar[XB_XGEN(b.x)]) == gen, bar);
            __builtin_amdgcn_fence(__ATOMIC_ACQUIRE, "agent");
            asm volatile("s_waitcnt vmcnt(0)" ::: "memory");
        }
    }
    __syncthreads();
}

constexpr int LDSP_OFF = 143360;
__device__ __forceinline__ unsigned long long ldsp64(LAS const unsigned* P, int i) {
    const unsigned lo = __builtin_amdgcn_readfirstlane(P[2 * i]), hi = __builtin_amdgcn_readfirstlane(P[2 * i + 1]); return ((unsigned long long)hi << 32) | lo; }
__device__ __forceinline__ Params load_params(LAS unsigned char* lds) {
    LAS const unsigned* P = (LAS const unsigned*)(lds + LDSP_OFF);
    Params q;
    q.in[0] = (const float*)(const __attribute__((address_space(1))) float*)ldsp64(P, 0);
    q.in[1] = (const float*)(const __attribute__((address_space(1))) float*)ldsp64(P, 1);
    q.in[2] = (const float*)(const __attribute__((address_space(1))) float*)ldsp64(P, 2);
    q.in[3] = (const float*)(const __attribute__((address_space(1))) float*)ldsp64(P, 3);
    q.in[4] = (const float*)(const __attribute__((address_space(1))) float*)ldsp64(P, 4);
    q.in[5] = (const float*)(const __attribute__((address_space(1))) float*)ldsp64(P, 5);
    q.in[6] = (const float*)(const __attribute__((address_space(1))) float*)ldsp64(P, 6);
    q.in[7] = (const float*)(const __attribute__((address_space(1))) float*)ldsp64(P, 7);
    q.in[8] = (const float*)(const __attribute__((address_space(1))) float*)ldsp64(P, 8);
    q.in[9] = (const float*)(const __attribute__((address_space(1))) float*)ldsp64(P, 9);
    q.in[10] = (const float*)(const __attribute__((address_space(1))) float*)ldsp64(P, 10);
    q.in[11] = (const float*)(const __attribute__((address_space(1))) float*)ldsp64(P, 11);
    q.in[12] = (const float*)(const __attribute__((address_space(1))) float*)ldsp64(P, 12);
    q.in[13] = (const float*)(const __attribute__((address_space(1))) float*)ldsp64(P, 13);
    q.in[14] = (const float*)(const __attribute__((address_space(1))) float*)ldsp64(P, 14);
    q.in[15] = (const float*)(const __attribute__((address_space(1))) float*)ldsp64(P, 15);
    q.in[16] = (const float*)(const __attribute__((address_space(1))) float*)ldsp64(P, 16);
    q.in[17] = (const float*)(const __attribute__((address_space(1))) float*)ldsp64(P, 17);
    q.in[18] = (const float*)(const __attribute__((address_space(1))) float*)ldsp64(P, 18);
    q.in[19] = (const float*)(const __attribute__((address_space(1))) float*)ldsp64(P, 19);
    q.in[20] = (const float*)(const __attribute__((address_space(1))) float*)ldsp64(P, 20);
    q.in[21] = (const float*)(const __attribute__((address_space(1))) float*)ldsp64(P, 21);
    q.in[22] = (const float*)(const __attribute__((address_space(1))) float*)ldsp64(P, 22);
    q.out = (float*)(__attribute__((address_space(1))) float*)ldsp64(P, 23); q.ws = (unsigned char*)(__attribute__((address_space(1))) unsigned char*)ldsp64(P, 24);
    q.lam_init[0] = __uint_as_float(__builtin_amdgcn_readfirstlane(P[50]));
    q.lam_init[1] = __uint_as_float(__builtin_amdgcn_readfirstlane(P[51]));
    q.lam_init[2] = __uint_as_float(__builtin_amdgcn_readfirstlane(P[52]));
    q.lam_init[3] = __uint_as_float(__builtin_amdgcn_readfirstlane(P[53]));
    q.lo = 0; q.hi = 0;
    return q;
}
__global__ void __launch_bounds__(512) fwd_kernel(Params kp) {
    extern __shared__ __attribute__((aligned(16))) unsigned char lds_raw[];
    LAS unsigned char* lds = (LAS unsigned char*)lds_raw;
    const int G = gridDim.x, lo = kp.lo, hi = kp.hi;
    if (threadIdx.x == 0) { LAS unsigned long long* P = (LAS unsigned long long*)(lds + LDSP_OFF);
        P[0] = (unsigned long long)kp.in[0];
        P[1] = (unsigned long long)kp.in[1];
        P[2] = (unsigned long long)kp.in[2];
        P[3] = (unsigned long long)kp.in[3];
        P[4] = (unsigned long long)kp.in[4];
        P[5] = (unsigned long long)kp.in[5];
        P[6] = (unsigned long long)kp.in[6];
        P[7] = (unsigned long long)kp.in[7];
        P[8] = (unsigned long long)kp.in[8];
        P[9] = (unsigned long long)kp.in[9];
        P[10] = (unsigned long long)kp.in[10];
        P[11] = (unsigned long long)kp.in[11];
        P[12] = (unsigned long long)kp.in[12];
        P[13] = (unsigned long long)kp.in[13];
        P[14] = (unsigned long long)kp.in[14];
        P[15] = (unsigned long long)kp.in[15];
        P[16] = (unsigned long long)kp.in[16];
        P[17] = (unsigned long long)kp.in[17];
        P[18] = (unsigned long long)kp.in[18];
        P[19] = (unsigned long long)kp.in[19];
        P[20] = (unsigned long long)kp.in[20];
        P[21] = (unsigned long long)kp.in[21];
        P[22] = (unsigned long long)kp.in[22];
        P[23] = (unsigned long long)kp.out; P[24] = (unsigned long long)kp.ws;
        LAS float* Pf = (LAS float*)(lds + LDSP_OFF + 200);
        Pf[0] = kp.lam_init[0]; Pf[1] = kp.lam_init[1]; Pf[2] = kp.lam_init[2]; Pf[3] = kp.lam_init[3];
        volatile LAS unsigned* st = (volatile LAS unsigned*)(lds + LDSP_OFF + 256); st[0] = 0u; st[1] = 0u; }
    __syncthreads();
    if (hi - lo > 2) { const XcdBarrier b0 = xcd_barrier_post((unsigned*)kp.ws, (volatile LAS unsigned*)(lds + LDSP_OFF + 256)); if (threadIdx.x == 0) ((volatile LAS unsigned*)(lds + LDSP_OFF + 256))[2] = b0.x; }
    __syncthreads();
#define FRESH() int tid = threadIdx.x; asm volatile("" : "+v"(tid)); const int lane = tid & 63, wid = __builtin_amdgcn_readfirstlane(tid >> 6); (void)lane; (void)wid; (void)tid; const Params p = load_params(lds); unsigned char* ws = p.ws; (void)ws
    int ph = 0;
#ifndef PHM
#define PHM 0xffff
#endif
#define RUNS(k) ((k) >= lo && (k) < hi)
#define SEAM() do { if (RUNS(ph) && RUNS(ph + 1)) { if (ph == 0) cg::this_grid().sync(); else { XcdBarrier xb_; xb_.bar = (unsigned*)(__attribute__((address_space(1))) unsigned*)ldsp64((LAS const unsigned*)(lds + LDSP_OFF), 24); \
        xb_.x = ((volatile LAS unsigned*)(lds + LDSP_OFF + 256))[2]; xb_.st = (volatile LAS unsigned*)(lds + LDSP_OFF + 256); xcd_barrier(xb_); } } ++ph; } while (0)
    if ((PHM & 1) && RUNS(ph)) { FRESH(); prologue_phase(p, lds, tid, wid, lane); __syncthreads(); convert_layer_weights(p, 0, lds, wid, lane); }
    SEAM();
    for (int layer = 0; layer < DEPTH; ++layer) {
        const bool last = layer == DEPTH - 1;
        const int M = last ? RL : RT;
        if ((PHM & 2) && RUNS(ph)) { FRESH(); if (layer > 0) convert_layer_weights(p, layer, lds, wid, lane); norm_phase(p, layer, 0, RT, wid, lane); }
        SEAM();
        if ((PHM & 4) && RUNS(ph)) for (int rep = 0; rep < (DUP_GEMM ? 2 : 1); ++rep) { FRESH();
            EpiG1 E{(bf16_t*)(ws + WS_K), (bf16_t*)(ws + WS_VT), (bf16_t*)(ws + WS_Q), (bf16_t*)(ws + WS_U), (bf16_t*)(ws + WS_SV), (bf16_t*)(ws + WS_G), (const float*)(ws + WS_ROPE), 0};
            pg8::Gemm g{(const bf16_t*)(ws + WS_H), (const bf16_t*)(ws + WS_WIN), M, INW, DM}; pg8::StaticOrder S; S.init(M, INW, G, (int)blockIdx.x);
            pg8::gemm_phase<EpiG1, pg8::StaticOrder, true, true>(lds, g, S, E);
            if (last) {
                EpiG1 E2 = E; E2.row_off = RL;
                pg8::Gemm g2{(const bf16_t*)(ws + WS_H) + (size_t)RL * DM, (const bf16_t*)(ws + WS_WIN), RC, 1024, DM}; pg8::StaticOrder S2; S2.init(RC, 1024, G, (int)blockIdx.x);
                pg8::gemm_phase<EpiG1, pg8::StaticOrder, true, true>(lds, g2, S2, E2);
            }
        }
        SEAM();
        if ((PHM & 8) && RUNS(ph)) { FRESH(); mixer_phase(p, layer, last, lds, tid, wid, lane); }
        SEAM();
        if ((PHM & 16) && RUNS(ph)) for (int rep = 0; rep < (DUP_GEMM ? 2 : 1); ++rep) { FRESH();
            pg8::StaticOrder S; S.init(M, DM, G, (int)blockIdx.x);
            { EpiMerge<1> E{(const bf16_t*)(ws + WS_G), (bf16_t*)(ws + WS_H)}; pg8::Gemm g{(const bf16_t*)(ws + WS_O), (const bf16_t*)(ws + WS_WA), M, DM, 512};
              pg8::gemm_phase<EpiMerge<1>, pg8::StaticOrder, true, true>(lds, g, S, E); }
            { EpiMerge<2> E{(const bf16_t*)(ws + WS_G), (bf16_t*)(ws + WS_H)}; pg8::Gemm g{(const bf16_t*)(ws + WS_U), (const bf16_t*)(ws + WS_WSG), M, DM, 512};
              pg8::gemm_phase<EpiMerge<2>, pg8::StaticOrder, true, true>(lds, g, S, E); }
        }
        SEAM();
        if ((PHM & 32) && RUNS(ph)) { FRESH();
            const float* modl = (const float*)(ws + WS_MOD) + (size_t)layer * 17 * 6144;
            const float* xl_in = layer == 0 ? p.in[0] : p.out; const float* xc_in = layer == 0 ? p.in[2] : (const float*)(ws + WS_XC);
            EpiResid E{xl_in, xc_in, p.out, (float*)(ws + WS_XC), modl + 2 * DM};
            pg8::Gemm g{(const bf16_t*)(ws + WS_H), (const bf16_t*)(ws + WS_WO), M, DM, DM}; pg8::StaticOrder S; S.init(M, DM, G, (int)blockIdx.x);
            pg8::gemm_phase<EpiResid, pg8::StaticOrder, true, true>(lds, g, S, E);
        }
        SEAM();
        if ((PHM & 64) && RUNS(ph)) { FRESH(); norm_phase(p, layer, 1, M, wid, lane); }
        SEAM();
        if ((PHM & 128) && RUNS(ph)) for (int rep = 0; rep < (DUP_GEMM ? 2 : 1); ++rep) { FRESH();
            EpiFfn1 E{(bf16_t*)(ws + WS_ACT)};
            pg8::Gemm g{(const bf16_t*)(ws + WS_H), (const bf16_t*)(ws + WS_WF1), M, 2 * DFF, DM}; pg8::StaticOrder S; S.init(M, 2 * DFF, G, (int)blockIdx.x);
            pg8::gemm_phase<EpiFfn1, pg8::StaticOrder, true, true>(lds, g, S, E);
        }
        SEAM();
        if ((PHM & 256) && RUNS(ph)) { FRESH();
            const float* modl = (const float*)(ws + WS_MOD) + (size_t)layer * 17 * 6144;
            EpiResid E{p.out, (const float*)(ws + WS_XC), p.out, (float*)(ws + WS_XC), modl + 5 * DM};
            pg8::Gemm g{(const bf16_t*)(ws + WS_ACT), (const bf16_t*)(ws + WS_WF2), M, DM, DFF}; pg8::StaticOrder S; S.init(M, DM, G, (int)blockIdx.x);
            pg8::gemm_phase<EpiResid, pg8::StaticOrder, true, true>(lds, g, S, E);
        }
        SEAM();
    }
    if ((PHM & 512) && RUNS(ph)) { FRESH(); final_phase(p, wid, lane); }
#undef RUNS
#undef SEAM
}

extern "C" void kernel_launch(void* const* d_in, const int* in_sizes, int n_in, void* d_out, int out_size, void* d_ws, size_t ws_size, hipStream_t stream) {
    static int grid = 0;
    if (grid == 0) {
        if (n_in != 23 || out_size != RL * DM || ws_size < WS_END) { fprintf(stderr, "kernel_launch: unexpected shapes (n_in %d out %d ws %zu)\n", n_in, out_size, ws_size); grid = -1; return; }
        int dev = 0, cus = 0, per_cu = 0;
        hipGetDevice(&dev); hipDeviceGetAttribute(&cus, hipDeviceAttributeMultiprocessorCount, dev);
        if (hipFuncSetAttribute((const void*)fwd_kernel, hipFuncAttributeMaxDynamicSharedMemorySize, LDS_BYTES) != hipSuccess) { fprintf(stderr, "kernel_launch: hipFuncSetAttribute failed\n"); grid = -1; return; }
        if (hipOccupancyMaxActiveBlocksPerMultiprocessor(&per_cu, (const void*)fwd_kernel, 512, LDS_BYTES) != hipSuccess || per_cu < 1) { fprintf(stderr, "kernel_launch: occupancy query says %d\n", per_cu); per_cu = 1; }
        (void)hipGetLastError();
        grid = cus * per_cu;
        if (grid > 256) grid = 256;
    }
    if (grid < 0) return;
    Params p{};
    for (int i = 0; i < 23; ++i) p.in[i] = (const float*)d_in[i];
    p.out = (float*)d_out; p.ws = (unsigned char*)d_ws;
    for (int i = 0; i < 4; ++i) p.lam_init[i] = (float)(0.8 - 0.6 * std::exp(-0.3 * (double)i));
#if COOP
    if (hipMemsetAsync(d_ws, 0, 16384, stream) != hipSuccess) { fprintf(stderr, "kernel_launch: memset of barrier words failed\n"); return; }
    p.lo = 0; p.hi = NPHASE;
    void* args[] = {&p};
    hipError_t e = hipLaunchCooperativeKernel((const void*)fwd_kernel, dim3(grid), dim3(512), args, LDS_BYTES, stream);
    if (e != hipSuccess) fprintf(stderr, "cooperative launch failed: %s (grid %d)\n", hipGetErrorString(e), grid);
#else
    for (int k = 0; k < NPHASE; ++k) { p.lo = k; p.hi = k + 1; hipLaunchKernelGGL(fwd_kernel, dim3(grid), dim3(512), LDS_BYTES, stream, p); }
#endif
}
```

```cpp
#include <hip/hip_runtime.h>
#include <hip/hip_cooperative_groups.h>
#include <cstdio>
#include <cstdint>
#include <cmath>
namespace cg = cooperative_groups;
#ifndef COOP
#define COOP 1
#endif
#ifndef DUP_GEMM
#define DUP_GEMM 0
#endif
#ifndef DUP_ATTN
#define DUP_ATTN 0
#endif
namespace pg8 {
#define PG8_LAS __attribute__((address_space(3)))
typedef unsigned short bf16_t;
typedef short bf16x8 __attribute__((ext_vector_type(8)));
typedef float f32x4 __attribute__((ext_vector_type(4)));
typedef unsigned u32x4 __attribute__((ext_vector_type(4)));
constexpr int BM = 256, BK = 64, HALF = 128, HTB = HALF * BK * 2  , STAGE_BYTES = 8 * HTB, NXCD = 8, WGM = 8;

__host__ __device__ __forceinline__ int lds_byte(int r, int c) { const int st = (r >> 4) * 2 + (c >> 5), rr = r & 15, cc = c & 31, ob = rr * 64 + cc * 2; return st * 1024 + (ob ^ (((ob >> 9) & 1) << 5)); }
__host__ __device__ __forceinline__ void stage_rc(int b, int& R, int& C) { const int st = b / 1024, sb = b % 1024, swz = sb ^ (((sb >> 9) & 1) << 5); R = (st >> 1) * 16 + swz / 64; C = (st & 1) * 32 + (swz % 64) / 2; }
__host__ __device__ __forceinline__ int perm32(int rho) { const int n = rho >> 4, i = rho & 15; return 8 * (i >> 2) + 4 * n + (i & 3); }

struct Unit { int pm, pn; };
struct Gemm { const bf16_t* A; const bf16_t* Bt; int M, N, K; };

struct StaticOrder {
    int nM, nN, nwg, G, c;
    __host__ __device__ void init(int M, int N, int G_, int c_) { nM = M / BM; nN = N / BM; nwg = nM * nN; G = G_; c = c_; }
    __host__ __device__ bool next(int i, Unit& u) const {
        const long L = (long)i * G + c; if (L >= nwg) return false;
        int wgid = (int)L; { const int q = nwg / NXCD, r = nwg % NXCD, xcd = wgid % NXCD, off = wgid / NXCD; wgid = (xcd < r ? xcd * (q + 1) : r * (q + 1) + (xcd - r) * q) + off; }
        const int nig = WGM * nN, gid = wgid / nig, fm = gid * WGM, gsz = (nM - fm) < WGM ? (nM - fm) : WGM;
        u.pm = fm + ((wgid % nig) % gsz); u.pn = (wgid % nig) / gsz; return true;
    }
    __device__ __forceinline__ void a_ready(const Unit&) const {}
    __device__ __forceinline__ void done(const Unit&) const {}
};

__device__ __forceinline__ unsigned cvt_pk_bf16(float lo, float hi) { unsigned r; asm volatile("v_cvt_pk_bf16_f32 %0, %1, %2" : "=v"(r) : "v"(lo), "v"(hi)); return r; }
typedef float f32x2 __attribute__((ext_vector_type(2)));
template <class Epi, class Sched, bool ALIGN_EPI = false, bool SP2 = false>
__device__ __forceinline__ void gemm_phase(PG8_LAS unsigned char* lds, const Gemm g, const Sched& S, const Epi& E) {
    int tid_ = threadIdx.x; asm volatile("" : "+v"(tid_));
    const int tid = tid_, wid = __builtin_amdgcn_readfirstlane(tid >> 6), lane = tid & 63, wr = wid >> 2, wc = wid & 3, fr = lane & 15, fq = lane >> 4;
    const int K = g.K, nt = K / BK;
    unsigned voffA[2], voffB[2];
#pragma unroll
    for (int i = 0; i < 2; ++i) { int R, C; stage_rc(tid * 16 + i * 8192, R, C); const int Rb = Epi::PERM ? ((R & ~31) + perm32(R & 31)) : R;
        voffA[i] = (unsigned)(R * K + C) * 2u; voffB[i] = (unsigned)(Rb * K + C) * 2u; }
    const size_t kstep = (size_t)(BK * 2);
    const size_t hstep = (size_t)HALF * K * 2;
    const size_t tstep = 2 * hstep;
    const unsigned ldsw = (unsigned)wid * 1024u;
    const int aoff = lds_byte(wr * 64 + fr, fq * 8), boff = lds_byte(wc * 32 + fr, fq * 8);
#define PG8_SA(b, h) (((b) * 2 + (h)) * HTB)
#define PG8_SB(b, h) ((4 + (b) * 2 + (h)) * HTB)
#define PG8_STAGE(bufoff, gbase, voff) do { _Pragma("unroll") for (int _i = 0; _i < 2; ++_i) \
        __builtin_amdgcn_global_load_lds((const unsigned*)((const char*)(gbase) + (voff)[_i]), (PG8_LAS unsigned*)(lds + (bufoff) + ldsw + _i * 8192), 16, 0, 0); } while (0)
#define PG8_LDA(dst, b, h) do { _Pragma("unroll") for (int m = 0; m < 4; ++m) _Pragma("unroll") for (int k = 0; k < 2; ++k) dst[m][k] = *(const PG8_LAS bf16x8*)(lds + PG8_SA(b, h) + aoff + m * 2048 + k * 1024); } while (0)
#define PG8_LDB(dst, b, h) do { _Pragma("unroll") for (int n = 0; n < 2; ++n) _Pragma("unroll") for (int k = 0; k < 2; ++k) dst[n][k] = *(const PG8_LAS bf16x8*)(lds + PG8_SB(b, h) + boff + n * 2048 + k * 1024); } while (0)
#define PG8_MMA(ai, bj, At, Bt) do { __builtin_amdgcn_s_setprio(1); _Pragma("unroll") for (int m = 0; m < 4; ++m) _Pragma("unroll") for (int n = 0; n < 2; ++n) _Pragma("unroll") for (int k = 0; k < 2; ++k) \
        acc[ai][bj][m][n] = __builtin_amdgcn_mfma_f32_16x16x32_bf16(Bt[n][k], At[m][k], acc[ai][bj][m][n], 0, 0, 0); __builtin_amdgcn_s_setprio(0); } while (0)
#define PG8_WAIT_V(n) asm volatile("s_waitcnt vmcnt(" #n ")" ::: "memory")
#define PG8_WAIT_L(n) asm volatile("s_waitcnt lgkmcnt(" #n ")" ::: "memory")
#define PG8_BAR __builtin_amdgcn_s_barrier()
#define PG8_SCHED __builtin_amdgcn_sched_barrier(0)
    Unit cur, nxt; int ui = 0;
    if (!S.next(0, cur)) return;
    f32x4 acc[2][2][4][2];
#pragma unroll
    for (int a = 0; a < 2; ++a)
#pragma unroll
        for (int b = 0; b < 2; ++b)
#pragma unroll
            for (int m = 0; m < 4; ++m)
#pragma unroll
                for (int n = 0; n < 2; ++n) acc[a][b][m][n] = (f32x4){0.f, 0.f, 0.f, 0.f};
    bf16x8 At[4][2], B0[2][2], B1[2][2];
    const char* cA = (const char*)g.A + (size_t)cur.pm * tstep; const char* cB = (const char*)g.Bt + (size_t)cur.pn * tstep;
    S.a_ready(cur);
    if constexpr (SP2) {
        PG8_STAGE(PG8_SB(0, 0), cB, voffB); PG8_STAGE(PG8_SB(0, 1), cB + hstep, voffB); PG8_STAGE(PG8_SA(0, 0), cA, voffA); PG8_STAGE(PG8_SA(0, 1), cA + hstep, voffA);
        if (wr == 1) PG8_BAR;
        PG8_WAIT_V(2); PG8_BAR;
        PG8_STAGE(PG8_SB(1, 0), cB + kstep, voffB); PG8_STAGE(PG8_SA(1, 0), cA + kstep, voffA); PG8_STAGE(PG8_SB(1, 1), cB + hstep + kstep, voffB);
        PG8_WAIT_V(6); PG8_BAR;
    } else {
        PG8_STAGE(PG8_SB(0, 0), cB, voffB); PG8_STAGE(PG8_SA(0, 0), cA, voffA); PG8_STAGE(PG8_SB(0, 1), cB + hstep, voffB); PG8_STAGE(PG8_SA(0, 1), cA + hstep, voffA);
        if (wr == 1) PG8_BAR;
        PG8_WAIT_V(4); PG8_BAR;
        PG8_STAGE(PG8_SB(1, 0), cB + kstep, voffB); PG8_STAGE(PG8_SA(1, 0), cA + kstep, voffA); PG8_STAGE(PG8_SB(1, 1), cB + hstep + kstep, voffB);
        PG8_WAIT_V(6); PG8_BAR;
    }
    for (;;) {
        const bool has_next = S.next(ui + 1, nxt);
        const char* nA = has_next ? (const char*)g.A + (size_t)nxt.pm * tstep : cA; const char* nB = has_next ? (const char*)g.Bt + (size_t)nxt.pn * tstep : cB;
        for (int t = 0; t < nt; t += 2) {
            const bool last = (t == nt - 2);
            const char* a1 = cA + (size_t)(t + 1) * kstep;
            const char* a2 = last ? nA : cA + (size_t)(t + 2) * kstep; const char* b2 = last ? nB : cB + (size_t)(t + 2) * kstep;
            const char* a3 = a2 + kstep; const char* b3 = b2 + kstep;
            if (last && has_next) S.a_ready(nxt);
            if constexpr (SP2) {
            PG8_LDB(B0, 0, 0); PG8_LDB(B1, 0, 1); PG8_SCHED; PG8_LDA(At, 0, 0); PG8_STAGE(PG8_SA(1, 1), a1 + hstep, voffA);
            PG8_WAIT_V(8); PG8_WAIT_L(0); PG8_BAR; PG8_MMA(0, 0, At, B0); PG8_MMA(0, 1, At, B1); PG8_BAR; PG8_SCHED;
            PG8_LDA(At, 0, 1); PG8_STAGE(PG8_SB(0, 0), b2, voffB); PG8_STAGE(PG8_SB(0, 1), b2 + hstep, voffB); PG8_STAGE(PG8_SA(0, 0), a2, voffA);
            PG8_WAIT_V(8); PG8_WAIT_L(0); PG8_BAR; PG8_MMA(1, 0, At, B0); PG8_MMA(1, 1, At, B1); PG8_BAR; PG8_SCHED;
            PG8_LDB(B0, 1, 0); PG8_LDB(B1, 1, 1); PG8_SCHED; PG8_LDA(At, 1, 0); PG8_STAGE(PG8_SA(0, 1), a2 + hstep, voffA);
            PG8_WAIT_V(8); PG8_WAIT_L(0); PG8_BAR; PG8_MMA(0, 0, At, B0); PG8_MMA(0, 1, At, B1); PG8_BAR; PG8_SCHED;
            PG8_LDA(At, 1, 1); PG8_STAGE(PG8_SB(1, 0), b3, voffB); PG8_STAGE(PG8_SB(1, 1), b3 + hstep, voffB); PG8_STAGE(PG8_SA(1, 0), a3, voffA);
            PG8_WAIT_V(8); PG8_WAIT_L(0); PG8_BAR; PG8_MMA(1, 0, At, B0); PG8_MMA(1, 1, At, B1); PG8_BAR; PG8_SCHED;
            } else {
            PG8_LDB(B0, 0, 0); PG8_SCHED; PG8_LDA(At, 0, 0); PG8_STAGE(PG8_SA(1, 1), a1 + hstep, voffA);
            PG8_WAIT_L(8); PG8_BAR; PG8_WAIT_L(0); PG8_MMA(0, 0, At, B0); PG8_BAR; PG8_SCHED;
            PG8_LDB(B1, 0, 1); PG8_STAGE(PG8_SB(0, 0), b2, voffB);
            PG8_BAR; PG8_WAIT_L(0); PG8_MMA(0, 1, At, B1); PG8_BAR;
            PG8_LDA(At, 0, 1); PG8_STAGE(PG8_SA(0, 0), a2, voffA);
            PG8_BAR; PG8_WAIT_L(0); PG8_MMA(1, 0, At, B0); PG8_BAR; PG8_SCHED;
            PG8_STAGE(PG8_SB(0, 1), b2 + hstep, voffB);
            PG8_WAIT_V(6); PG8_BAR; PG8_MMA(1, 1, At, B1); PG8_BAR;
            PG8_LDB(B0, 1, 0); PG8_SCHED; PG8_LDA(At, 1, 0); PG8_STAGE(PG8_SA(0, 1), a2 + hstep, voffA);
            PG8_WAIT_L(8); PG8_BAR; PG8_WAIT_L(0); PG8_MMA(0, 0, At, B0); PG8_BAR; PG8_SCHED;
            PG8_LDB(B1, 1, 1); PG8_STAGE(PG8_SB(1, 0), b3, voffB);
            PG8_BAR; PG8_WAIT_L(0); PG8_MMA(0, 1, At, B1); PG8_BAR;
            PG8_LDA(At, 1, 1); PG8_STAGE(PG8_SA(1, 0), a3, voffA);
            PG8_BAR; PG8_WAIT_L(0); PG8_MMA(1, 0, At, B0); PG8_BAR; PG8_SCHED;
            PG8_STAGE(PG8_SB(1, 1), b3 + hstep, voffB);
            PG8_WAIT_V(6); PG8_BAR; PG8_MMA(1, 1, At, B1); PG8_BAR;
            }
        }
        if constexpr (ALIGN_EPI) { if (wr == 0) PG8_BAR; }
        if constexpr (!Epi::AFTER_DRAIN) { E(acc, cur, wr, wc, fr, fq); S.done(cur); }
        if (!has_next) break;
#pragma unroll
        for (int a = 0; a < 2; ++a)
#pragma unroll
            for (int b = 0; b < 2; ++b)
#pragma unroll
                for (int m = 0; m < 4; ++m)
#pragma unroll
                    for (int n = 0; n < 2; ++n) acc[a][b][m][n] = (f32x4){0.f, 0.f, 0.f, 0.f};
        cur = nxt; cA = nA; cB = nB; ++ui;
        if constexpr (ALIGN_EPI) { if (wr == 1) PG8_BAR; }
    }
    PG8_WAIT_V(0);
    if constexpr (!ALIGN_EPI) { if (wr == 0) PG8_BAR; }
    PG8_BAR;
    if constexpr (Epi::AFTER_DRAIN) { E.fused(acc, cur, wr, wc, fr, fq, lds, wid, lane); S.done(cur); }
#undef PG8_SA
#undef PG8_SB
#undef PG8_STAGE
#undef PG8_LDA
#undef PG8_LDB
#undef PG8_MMA
#undef PG8_WAIT_V
#undef PG8_WAIT_L
#undef PG8_BAR
#undef PG8_SCHED
}
}

#define LAS __attribute__((address_space(3)))
using pg8::bf16_t; using pg8::bf16x8; using pg8::f32x4; using pg8::u32x4; using pg8::Unit;
typedef float f32x16 __attribute__((ext_vector_type(16)));
typedef unsigned u32x2 __attribute__((ext_vector_type(2)));
constexpr int DM = 1024, NB = 16, SEQ = 2048, CTXL = 256, DEPTH = 4;
constexpr int RL = NB * SEQ, RC = NB * CTXL, RT = RL + RC;
constexpr int INW = 4608, DFF = 2816, NKEYS = CTXL + SEQ;
constexpr float QSCALE = 0.125f * 1.4426950408889634f;
constexpr float EPS = 1e-6f;
constexpr size_t MiB = (size_t)1 << 20;
constexpr size_t WS_ROPE = 65536, WS_LAM = 131072, WS_MOD = 1 * MiB, WS_SGW = 3 * MiB;
constexpr size_t WS_WIN = 4 * MiB, WS_WA = 13 * MiB, WS_WSG = 14 * MiB, WS_WO = 15 * MiB, WS_WF1 = 17 * MiB, WS_WF2 = 28 * MiB;
constexpr size_t WS_XC = 34 * MiB, WS_H = 50 * MiB;
constexpr size_t WS_K = 122 * MiB, WS_VT = 158 * MiB, WS_Q = 194 * MiB, WS_U = 230 * MiB, WS_SV = 266 * MiB, WS_G = 302 * MiB, WS_ACT = 122 * MiB;
constexpr size_t WS_O = DUP_ATTN ? 446 * MiB : WS_Q;
constexpr size_t WS_END = (DUP_ATTN ? 482 : 446) * MiB;
constexpr int LDS_BYTES = 147456;
constexpr int NPHASE = 2 + 8 * DEPTH;

struct Params { const float* in[23]; float* out; unsigned char* ws; float lam_init[4]; int lo, hi; };

__device__ __forceinline__ float bf2f(unsigned short b) { return __uint_as_float((unsigned)b << 16); }
__device__ __forceinline__ float bflo(unsigned w) { return __uint_as_float(w << 16); }
__device__ __forceinline__ float bfhi(unsigned w) { return __uint_as_float(w & 0xffff0000u); }
__device__ __forceinline__ unsigned pk2(float lo, float hi) { return pg8::cvt_pk_bf16(lo, hi); }
__device__ __forceinline__ float fast_exp2(float x) { return __builtin_amdgcn_exp2f(x); }
__device__ __forceinline__ float fast_rcp(float x) { return __builtin_amdgcn_rcpf(x); }
__device__ __forceinline__ float sigmoidf_(float x) { return fast_rcp(1.0f + fast_exp2(-1.4426950408889634f * x)); }
__device__ __forceinline__ float siluf_(float x) { return x * sigmoidf_(x); }
__device__ __forceinline__ float geluf_(float x) { const float u = x * (0.7978845608028654f + 0.035677408136300125f * x * x); return x * fast_rcp(1.0f + fast_exp2(-2.8853900817779268f * u)); }
__device__ __forceinline__ float wave_sum(float v) {
#pragma unroll
    for (int o = 1; o < 64; o <<= 1) v += __shfl_xor(v, o);
    return v;
}
#define LDS_WAIT() asm volatile("s_waitcnt lgkmcnt(0)" ::: "memory")

struct EpiG1 {
    static constexpr bool PERM = true, AFTER_DRAIN = false;
    bf16_t *Kb, *VT, *Qb, *Ub, *SVb, *Gb; const float* rope; int row_off;
    __device__ __forceinline__ void operator()(const f32x4 (&acc)[2][2][4][2], const Unit& u, int wr, int wc, int fr, int fq) const {
        const int rbase = row_off + u.pm * 256 + wr * 64 + fr;
        const bool latent = (row_off + u.pm * 256) < RL;
        const int pn = u.pn, cw = wc * 32 + 8 * fq;
        if (pn >= 6) {
            const bool gate = pn >= 10;
            bf16_t* base; int ld;
            if (gate) { base = Gb + (pn - 10) * 256 + cw; ld = 2048; } else { base = (pn < 8 ? Ub : SVb) + (pn & 1) * 256 + cw; ld = 512; }
#pragma unroll
            for (int ai = 0; ai < 2; ++ai)
#pragma unroll
                for (int m = 0; m < 4; ++m) { bf16_t* rowp = base + (size_t)(rbase + ai * 128 + m * 16) * ld;
#pragma unroll
                    for (int bj = 0; bj < 2; ++bj) { const f32x4 v0 = acc[ai][bj][m][0], v1 = acc[ai][bj][m][1]; float y[8];
#pragma unroll
                        for (int j = 0; j < 4; ++j) { y[j] = gate ? sigmoidf_(v0[j]) : geluf_(v0[j]); y[4 + j] = gate ? sigmoidf_(v1[j]) : geluf_(v1[j]); }
                        u32x4 w; w.x = pk2(y[0], y[1]); w.y = pk2(y[2], y[3]); w.z = pk2(y[4], y[5]); w.w = pk2(y[6], y[7]);
                        *(u32x4*)(rowp + bj * 128) = w; } }
        } else if (pn == 2 || pn == 3) {
#pragma unroll
            for (int ai = 0; ai < 2; ++ai)
#pragma unroll
                for (int m = 0; m < 4; ++m) { const int row = rbase + ai * 128 + m * 16; int b, key;
                    if (latent) { b = row >> 11; key = CTXL + (row & 2047); } else { const int rc = row - RL; b = rc >> 8; key = rc & 255; }
                    const int pos = (key & ~12) | ((key & 4) << 1) | ((key & 8) >> 1);
#pragma unroll
                    for (int bj = 0; bj < 2; ++bj) { const int head = (pn & 1) * 2 + bj; bf16_t* p = VT + ((size_t)((b * 4 + head) * 128 + cw)) * NKEYS + pos;
                        const f32x4 v0 = acc[ai][bj][m][0], v1 = acc[ai][bj][m][1];
                        const unsigned w0 = pk2(v0[0], v0[1]), w1 = pk2(v0[2], v0[3]), w2 = pk2(v1[0], v1[1]), w3 = pk2(v1[2], v1[3]);
                        p[0 * NKEYS] = (bf16_t)(w0 & 0xffff); p[1 * NKEYS] = (bf16_t)(w0 >> 16); p[2 * NKEYS] = (bf16_t)(w1 & 0xffff); p[3 * NKEYS] = (bf16_t)(w1 >> 16);
                        p[4 * NKEYS] = (bf16_t)(w2 & 0xffff); p[5 * NKEYS] = (bf16_t)(w2 >> 16); p[6 * NKEYS] = (bf16_t)(w3 & 0xffff); p[7 * NKEYS] = (bf16_t)(w3 >> 16); } }
        } else {
            const bool isq = pn >= 4; bf16_t* base = (isq ? Qb : Kb) + (pn & 1) * 256 + cw; const float sc = isq ? QSCALE : 1.0f;
#pragma unroll
            for (int ai = 0; ai < 2; ++ai)
#pragma unroll
                for (int m = 0; m < 4; ++m) { const int row = rbase + ai * 128 + m * 16;
                    f32x4 cs = (f32x4){1.f, 1.f, 1.f, 1.f}, sn = (f32x4){0.f, 0.f, 0.f, 0.f};
                    if (latent) { const int s = row & 2047, pos = (wc & 1) ? (s & 63) : (s >> 6); cs = *(const f32x4*)(rope + pos * 32 + 4 * fq); sn = *(const f32x4*)(rope + pos * 32 + 16 + 4 * fq); }
                    cs = cs * sc; sn = sn * sc;
#pragma unroll
                    for (int bj = 0; bj < 2; ++bj) { const f32x4 v0 = acc[ai][bj][m][0], v1 = acc[ai][bj][m][1]; u32x4 w;
                        w.x = pk2(v0[0] * cs[0] - v0[1] * sn[0], v0[1] * cs[0] + v0[0] * sn[0]);
                        w.y = pk2(v0[2] * cs[1] - v0[3] * sn[1], v0[3] * cs[1] + v0[2] * sn[1]);
                        w.z = pk2(v1[0] * cs[2] - v1[1] * sn[2], v1[1] * cs[2] + v1[0] * sn[2]);
                        w.w = pk2(v1[2] * cs[3] - v1[3] * sn[3], v1[3] * cs[3] + v1[2] * sn[3]);
                        *(u32x4*)(base + (size_t)row * 512 + bj * 128) = w; } }
        }
    }
};
template <int STEP> struct EpiMerge {
    static constexpr bool PERM = true, AFTER_DRAIN = false;
    const bf16_t* Gb; bf16_t* Mb;
    __device__ __forceinline__ void operator()(const f32x4 (&acc)[2][2][4][2], const Unit& u, int wr, int wc, int fr, int fq) const {
        const int rbase = u.pm * 256 + wr * 64 + fr, col0 = u.pn * 256 + wc * 32 + 8 * fq;
#pragma unroll
        for (int ai = 0; ai < 2; ++ai)
#pragma unroll
            for (int m = 0; m < 4; ++m) { const size_t row = (size_t)(rbase + ai * 128 + m * 16);
#pragma unroll
                for (int bj = 0; bj < 2; ++bj) { const f32x4 v0 = acc[ai][bj][m][0], v1 = acc[ai][bj][m][1];
                    const u32x4 g = *(const u32x4*)(Gb + row * 2048 + (STEP - 1) * 1024 + col0 + bj * 128);
                    bf16_t* mp = Mb + row * 1024 + col0 + bj * 128; float y[8];
                    y[0] = bflo(g.x) * v0[0]; y[1] = bfhi(g.x) * v0[1]; y[2] = bflo(g.y) * v0[2]; y[3] = bfhi(g.y) * v0[3];
                    y[4] = bflo(g.z) * v1[0]; y[5] = bfhi(g.z) * v1[1]; y[6] = bflo(g.w) * v1[2]; y[7] = bfhi(g.w) * v1[3];
                    if (STEP == 2) { const u32x4 t = *(const u32x4*)mp;
                        y[0] += bflo(t.x); y[1] += bfhi(t.x); y[2] += bflo(t.y); y[3] += bfhi(t.y); y[4] += bflo(t.z); y[5] += bfhi(t.z); y[6] += bflo(t.w); y[7] += bfhi(t.w); }
                    u32x4 w; w.x = pk2(y[0], y[1]); w.y = pk2(y[2], y[3]); w.z = pk2(y[4], y[5]); w.w = pk2(y[6], y[7]);
                    *(u32x4*)mp = w; } }
    }
};
struct EpiResid {
    static constexpr bool PERM = false, AFTER_DRAIN = false;
    const float* base_l; const float* base_c; float* out_l; float* out_c; const float* gate;
    __device__ __forceinline__ void operator()(const f32x4 (&acc)[2][2][4][2], const Unit& u, int wr, int wc, int fr, int fq) const {
        const int row0 = u.pm * 256; const bool latent = row0 < RL;
        const float* gp = gate + (size_t)(latent ? (row0 >> 11) : 16) * 6144;
        const float* bp = latent ? base_l + (size_t)row0 * DM : base_c + (size_t)(row0 - RL) * DM;
        float* op = latent ? out_l + (size_t)row0 * DM : out_c + (size_t)(row0 - RL) * DM;
        const int col0 = u.pn * 256 + wc * 32 + 4 * fq;
        f32x4 gv[2][2];
#pragma unroll
        for (int bj = 0; bj < 2; ++bj)
#pragma unroll
            for (int n = 0; n < 2; ++n) gv[bj][n] = *(const f32x4*)(gp + col0 + bj * 128 + n * 16);
#pragma unroll
        for (int ai = 0; ai < 2; ++ai)
#pragma unroll
            for (int m = 0; m < 4; ++m) { const size_t off = (size_t)(wr * 64 + fr + ai * 128 + m * 16) * DM + col0;
#pragma unroll
                for (int bj = 0; bj < 2; ++bj)
#pragma unroll
                    for (int n = 0; n < 2; ++n) { const f32x4 b = *(const f32x4*)(bp + off + bj * 128 + n * 16); *(f32x4*)(op + off + bj * 128 + n * 16) = b + gv[bj][n] * acc[ai][bj][m][n]; } }
    }
};
struct EpiFfn1 {
    static constexpr bool PERM = true, AFTER_DRAIN = false;
    bf16_t* act;
    __device__ __forceinline__ void operator()(const f32x4 (&acc)[2][2][4][2], const Unit& u, int wr, int wc, int fr, int fq) const {
        const int rbase = u.pm * 256 + wr * 64 + fr, col0 = u.pn * 128 + wc * 32 + 8 * fq;
#pragma unroll
        for (int ai = 0; ai < 2; ++ai)
#pragma unroll
            for (int m = 0; m < 4; ++m) { const f32x4 a0 = acc[ai][0][m][0], a1 = acc[ai][0][m][1], b0 = acc[ai][1][m][0], b1 = acc[ai][1][m][1]; float y[8];
#pragma unroll
                for (int j = 0; j < 4; ++j) { y[j] = siluf_(a0[j]) * b0[j]; y[4 + j] = siluf_(a1[j]) * b1[j]; }
                u32x4 w; w.x = pk2(y[0], y[1]); w.y = pk2(y[2], y[3]); w.z = pk2(y[4], y[5]); w.w = pk2(y[6], y[7]);
                *(u32x4*)(act + (size_t)(rbase + ai * 128 + m * 16) * DFF + col0) = w; }
    }
};

template <int MODE> __device__ __forceinline__ void transpose_item(const float* W, int K, int N, bf16_t* WT, LAS float* scr, int item, int lane) {
    const int nblk = N / 32, kb = item / nblk, nb = item % nblk, k0 = 64 * kb, n0 = 32 * nb, i = lane & 31;
    int srccol;
    if (MODE == 1) { const bool qk = (n0 < 512) || (n0 >= 1024 && n0 < 1536); srccol = n0 + (qk ? ((i & 1) * 16 + (i >> 1)) : i); }
    else if (MODE == 2) { const int pn = nb >> 3, half = (nb >> 2) & 1, jb = nb & 3; srccol = half * DFF + 128 * pn + 32 * jb + i; }
    else srccol = n0 + i;
#pragma unroll 8
    for (int t = 0; t < 32; ++t) { const int kk = 2 * t + (lane >> 5); scr[kk * 33 + i] = W[(size_t)(k0 + kk) * N + srccol]; }
    LDS_WAIT();
    const int c = lane & 7;
#pragma unroll
    for (int j = 0; j < 4; ++j) { const int n = (lane >> 3) + 8 * j; const LAS float* s = scr + (8 * c) * 33 + n;
        u32x4 o; o.x = pk2(s[0 * 33], s[1 * 33]); o.y = pk2(s[2 * 33], s[3 * 33]); o.z = pk2(s[4 * 33], s[5 * 33]); o.w = pk2(s[6 * 33], s[7 * 33]);
        *(u32x4*)(WT + (size_t)(n0 + n) * K + k0 + 8 * c) = o; }
    LDS_WAIT();
}
constexpr int CV_IN = 16 * 144, CV_A = 8 * 32, CV_O = 16 * 32, CV_F1 = 16 * 176, CV_F2 = 44 * 32, CV_NIT = CV_IN + 2 * CV_A + CV_O + CV_F1 + CV_F2;
__device__ __forceinline__ void convert_layer_weights(const Params& p, int layer, int it_lo, int it_hi, int gw, int NGW, LAS unsigned char* lds, int wid, int lane) {
    LAS float* scr = (LAS float*)(lds + wid * 8448);
    unsigned char* ws = p.ws;
    const float* w_in = p.in[7] + (size_t)layer * DM * INW; const float* w_a = p.in[16] + (size_t)layer * 512 * DM; const float* w_sg = p.in[17] + (size_t)layer * 512 * DM;
    const float* w_o = p.in[18] + (size_t)layer * DM * DM; const float* w_f1 = p.in[20] + (size_t)layer * DM * 2 * DFF; const float* w_f2 = p.in[21] + (size_t)layer * DFF * DM;
    constexpr int I_IN = CV_IN, I_A = CV_A, I_O = CV_O, I_F1 = CV_F1;
    for (int it = it_lo + gw; it < it_hi; it += NGW) {
        int r = it;
        if (r < I_IN) { transpose_item<1>(w_in, DM, INW, (bf16_t*)(ws + WS_WIN), scr, r, lane); continue; } r -= I_IN;
        if (r < I_A) { transpose_item<0>(w_a, 512, DM, (bf16_t*)(ws + WS_WA), scr, r, lane); continue; } r -= I_A;
        if (r < I_A) { transpose_item<0>(w_sg, 512, DM, (bf16_t*)(ws + WS_WSG), scr, r, lane); continue; } r -= I_A;
        if (r < I_O) { transpose_item<0>(w_o, DM, DM, (bf16_t*)(ws + WS_WO), scr, r, lane); continue; } r -= I_O;
        if (r < I_F1) { transpose_item<2>(w_f1, DM, 2 * DFF, (bf16_t*)(ws + WS_WF1), scr, r, lane); continue; } r -= I_F1;
        transpose_item<0>(w_f2, DFF, DM, (bf16_t*)(ws + WS_WF2), scr, r, lane);
    }
}
__device__ __forceinline__ void norm_row(const float* xrow, bf16_t* hrow, const float* g, const float* sh, const float* sc, int lane) {
    f32x4 v[4]; float ss = 0.f;
#pragma unroll
    for (int j = 0; j < 4; ++j) { v[j] = ((const f32x4*)xrow)[lane + 64 * j]; ss += (v[j].x * v[j].x + v[j].y * v[j].y) + (v[j].z * v[j].z + v[j].w * v[j].w); }
    const float rstd = 1.0f / sqrtf(wave_sum(ss) * (1.0f / DM) + EPS);
#pragma unroll
    for (int j = 0; j < 4; ++j) { const f32x4 gg = ((const f32x4*)g)[lane + 64 * j], s1 = ((const f32x4*)sc)[lane + 64 * j], s0 = ((const f32x4*)sh)[lane + 64 * j];
        const f32x4 y = (v[j] * rstd) * gg * (s1 + 1.0f) + s0;
        u32x2 w; w.x = pk2(y.x, y.y); w.y = pk2(y.z, y.w); ((u32x2*)hrow)[lane + 64 * j] = w; }
}
__device__ __forceinline__ void norm_phase(const Params& p, int layer, int which  , int nrows, int wid, int lane) {
    const float* xl = (layer == 0 && which == 0) ? p.in[0] : p.out;
    const float* xc = (layer == 0 && which == 0) ? p.in[2] : (const float*)(p.ws + WS_XC);
    const float* g = (which == 0 ? p.in[6] : p.in[19]) + layer * DM;
    const float* mod = (const float*)(p.ws + WS_MOD) + (size_t)layer * 17 * 6144 + (which == 0 ? 0 : 3) * DM;
    bf16_t* H = (bf16_t*)(p.ws + WS_H);
    const int gw = blockIdx.x * 8 + wid, NGW = gridDim.x * 8;
    for (int r = gw; r < nrows; r += NGW) {
        const bool latent = r < RL; const int vec = latent ? (r >> 11) : 16;
        const float* xr = latent ? xl + (size_t)r * DM : xc + (size_t)(r - RL) * DM;
        norm_row(xr, H + (size_t)r * DM, g, mod + (size_t)vec * 6144, mod + (size_t)vec * 6144 + DM, lane);
    }
}
__device__ __forceinline__ void prologue_phase(const Params& p, LAS unsigned char* lds, int tid, int wid, int lane) {
    LAS float* sct = (LAS float*)lds;
    LAS float* red = (LAS float*)(lds + 81920);
    const float* c = p.in[1]; const float* cctx = p.in[3];
    for (int idx = tid; idx < 17 * 1024; idx += 512) { const int v = idx >> 10, k = idx & 1023; const float cv = (v < 16) ? c[v * 1024 + k] : cctx[k]; sct[k * 20 + v] = cv / (1.0f + expf(-cv)); }
    __syncthreads();
    float* mod = (float*)(p.ws + WS_MOD);
    for (int it = blockIdx.x; it < 4 * 96; it += gridDim.x) {
        const int layer = it / 96, nb = it % 96;
        const float* W = p.in[4] + (size_t)layer * DM * 6144 + nb * 64 + lane;
        float acc[17];
#pragma unroll
        for (int v = 0; v < 17; ++v) acc[v] = 0.f;
#pragma unroll 16
        for (int kk = 0; kk < 128; ++kk) { const int k = wid * 128 + kk; const float w = W[(size_t)k * 6144];
            const LAS f32x4* s4 = (const LAS f32x4*)(sct + k * 20);
            const f32x4 a = s4[0], b = s4[1], cc = s4[2], d = s4[3], e = s4[4];
            acc[0] += w * a.x; acc[1] += w * a.y; acc[2] += w * a.z; acc[3] += w * a.w; acc[4] += w * b.x; acc[5] += w * b.y; acc[6] += w * b.z; acc[7] += w * b.w;
            acc[8] += w * cc.x; acc[9] += w * cc.y; acc[10] += w * cc.z; acc[11] += w * cc.w; acc[12] += w * d.x; acc[13] += w * d.y; acc[14] += w * d.z; acc[15] += w * d.w; acc[16] += w * e.x; }
#pragma unroll
        for (int v = 0; v < 17; ++v) red[(wid * 17 + v) * 64 + lane] = acc[v];
        __syncthreads();
        for (int o = tid; o < 17 * 64; o += 512) { const int v = o >> 6, l = o & 63; float s = 0.f;
#pragma unroll
            for (int w = 0; w < 8; ++w) s += red[(w * 17 + v) * 64 + l];
            mod[((size_t)layer * 17 + v) * 6144 + nb * 64 + l] = s + p.in[5][layer * 6144 + nb * 64 + l]; }
        __syncthreads();
    }
    if (blockIdx.x == 0) {
        float* rope = (float*)(p.ws + WS_ROPE);
        for (int t = tid; t < 1024; t += 512) { const int pos = t >> 4, m = t & 15;
            double pw = 1.0; for (int i = 0; i < (m >> 2); ++i) pw *= 10.0;
            pw *= (m & 3) == 0 ? 1.0 : (m & 3) == 1 ? 1.7782794100389228 : (m & 3) == 2 ? 3.1622776601683795 : 5.623413251903491;
            const float inv = 1.0f / (float)pw; const float angf = (float)pos * inv;
            double a = (double)angf; const double twopi = 6.283185307179586476925286766559; a -= twopi * rint(a / twopi);
            double sn = 0.0, cs = 0.0, term = 1.0;
            for (int n = 0; n < 30; n += 2) { cs += ((n & 2) ? -term : term); term *= a / (double)(n + 1); sn += ((n & 2) ? -term : term); term *= a / (double)(n + 2); }
            rope[pos * 32 + m] = (float)cs; rope[pos * 32 + 16 + m] = (float)sn; }
    }
    if (blockIdx.x == 1 && wid < 4) {
        const float a = p.in[8][wid * 64 + lane] * p.in[9][wid * 64 + lane], b = p.in[10][wid * 64 + lane] * p.in[11][wid * 64 + lane];
        const float sa = wave_sum(a), sb = wave_sum(b);
        if (lane == 0) ((float*)(p.ws + WS_LAM))[wid] = expf(sa) - expf(sb) + ((const LAS float*)(lds + 143360 + 200))[wid];
    }
    { bf16_t* sgw = (bf16_t*)(p.ws + WS_SGW); const float* src = p.in[14];
      for (int i = blockIdx.x * 512 + tid; i < 4 * 4 * 128 * 128 / 2; i += gridDim.x * 512) ((unsigned*)sgw)[i] = pk2(src[2 * i], src[2 * i + 1]); }
}

struct AttnArgs { const bf16_t* Q; const bf16_t* K; const bf16_t* VT; bf16_t* O; const float* subln; float lam, oscale; };
constexpr int AKB = 64 * 272, AVB = 128 * 144;
__device__ __forceinline__ void attn_unit(LAS unsigned char* lds, const AttnArgs& a, int b, int h, int qrow0, int ntiles, int tid, int wid, int lane) {
    const int qb = wid >> 1, mp = wid & 1, r32 = lane & 31, hi = lane >> 5;
    const int kch = tid & 15, krow = tid >> 4, vch = tid & 7, vrow = tid >> 3;
    const bf16_t* kctx = a.K + (size_t)(RL + b * CTXL + krow) * 512 + h * 128 + kch * 8;
    const bf16_t* klat = a.K + (size_t)(b * SEQ + krow) * 512 + h * 128 + kch * 8;
    const bf16_t* vsrc = a.VT + ((size_t)((b * 4 + h) * 128 + vrow)) * NKEYS + vch * 8;
    u32x4 kr0, kr1, vr0, vr1;
#define ATT_LOADK(j) do { const bf16_t* kp_ = ((j) < 4) ? kctx + (size_t)(64 * (j)) * 512 : klat + (size_t)(64 * ((j) - 4)) * 512; kr0 = *(const u32x4*)kp_; kr1 = *(const u32x4*)(kp_ + 32 * 512); } while (0)
#define ATT_LOADV(j) do { vr0 = *(const u32x4*)(vsrc + 64 * (j)); vr1 = *(const u32x4*)(vsrc + (size_t)64 * NKEYS + 64 * (j)); } while (0)
#define ATT_STOREK(j) do { *(LAS u32x4*)(lds + ((j) & 1) * AKB + krow * 272 + kch * 16) = kr0; *(LAS u32x4*)(lds + ((j) & 1) * AKB + (krow + 32) * 272 + kch * 16) = kr1; } while (0)
#define ATT_STOREV(j) do { *(LAS u32x4*)(lds + 2 * AKB + ((j) & 1) * AVB + vrow * 144 + vch * 16) = vr0; *(LAS u32x4*)(lds + 2 * AKB + ((j) & 1) * AVB + (vrow + 64) * 144 + vch * 16) = vr1; } while (0)
    bf16x8 qf[4];
    { const bf16_t* qp = a.Q + (size_t)(qrow0 + qb * 32 + r32) * 512 + h * 128 + mp * 64 + hi * 8;
#pragma unroll
      for (int ks = 0; ks < 4; ++ks) qf[ks] = *(const bf16x8*)(qp + ks * 16); }
    ATT_LOADK(0); ATT_STOREK(0);
    __syncthreads();
    f32x16 o[4];
#pragma unroll
    for (int d = 0; d < 4; ++d)
#pragma unroll
        for (int r = 0; r < 16; ++r) o[d][r] = 0.f;
    float mref = 0.f, lsum = 0.f, alpha_pend = 1.f; bool pend = false; f32x16 s0, s1; bf16x8 pf[4];
    const f32x16 zero16 = {0.f, 0.f, 0.f, 0.f, 0.f, 0.f, 0.f, 0.f, 0.f, 0.f, 0.f, 0.f, 0.f, 0.f, 0.f, 0.f};
    constexpr float THR = 8.0f;
#define ATT_QK(t) do { const LAS unsigned char* Kp = lds + ((t) & 1) * AKB + r32 * 272 + (mp * 64 + hi * 8) * 2; \
        _Pragma("unroll") for (int ks = 0; ks < 4; ++ks) { \
            const bf16x8 k0 = *(const LAS bf16x8*)(Kp + ks * 32), k1 = *(const LAS bf16x8*)(Kp + 32 * 272 + ks * 32); \
            if (ks == 0) { s0 = __builtin_amdgcn_mfma_f32_32x32x16_bf16(k0, qf[0], zero16, 0, 0, 0); s1 = __builtin_amdgcn_mfma_f32_32x32x16_bf16(k1, qf[0], zero16, 0, 0, 0); } \
            else { s0 = __builtin_amdgcn_mfma_f32_32x32x16_bf16(k0, qf[ks], s0, 0, 0, 0); s1 = __builtin_amdgcn_mfma_f32_32x32x16_bf16(k1, qf[ks], s1, 0, 0, 0); } } } while (0)
#define ATT_CHECK(first) do { float mx = __builtin_fmaxf(__builtin_fmaxf(s0[0], s1[0]), s0[1]); \
        _Pragma("unroll") for (int r = 2; r < 16; r += 2) mx = __builtin_fmaxf(__builtin_fmaxf(mx, s0[r]), s0[r + 1]); \
        _Pragma("unroll") for (int r = 1; r < 16; r += 2) mx = __builtin_fmaxf(__builtin_fmaxf(mx, s1[r]), s1[(r + 1) & 15]); \
        pend = false; \
        if ((first) || __any(mx - mref > THR)) { mx = fmaxf(mx, __shfl_xor(mx, 32)); \
            const float nref = (first) ? mx : fmaxf(mx, mref); alpha_pend = fast_exp2(mref - nref); mref = nref; lsum *= alpha_pend; pend = !(first); } } while (0)
#define ATT_EXPSUM() do { float ps = 0.f; _Pragma("unroll") for (int r = 0; r < 16; ++r) { s0[r] = fast_exp2(s0[r] - mref); s1[r] = fast_exp2(s1[r] - mref); ps += s0[r] + s1[r]; } lsum += ps; } while (0)
#define ATT_PACK() do { u32x4 w; \
        w.x = pk2(s0[0], s0[1]); w.y = pk2(s0[2], s0[3]); w.z = pk2(s0[4], s0[5]); w.w = pk2(s0[6], s0[7]); pf[0] = __builtin_bit_cast(bf16x8, w); \
        w.x = pk2(s0[8], s0[9]); w.y = pk2(s0[10], s0[11]); w.z = pk2(s0[12], s0[13]); w.w = pk2(s0[14], s0[15]); pf[1] = __builtin_bit_cast(bf16x8, w); \
        w.x = pk2(s1[0], s1[1]); w.y = pk2(s1[2], s1[3]); w.z = pk2(s1[4], s1[5]); w.w = pk2(s1[6], s1[7]); pf[2] = __builtin_bit_cast(bf16x8, w); \
        w.x = pk2(s1[8], s1[9]); w.y = pk2(s1[10], s1[11]); w.z = pk2(s1[12], s1[13]); w.w = pk2(s1[14], s1[15]); pf[3] = __builtin_bit_cast(bf16x8, w); } while (0)
#define ATT_PV(t) do { const LAS unsigned char* Vp = lds + 2 * AKB + ((t) & 1) * AVB + r32 * 144 + hi * 16; \
        _Pragma("unroll") for (int s4 = 0; s4 < 4; ++s4) _Pragma("unroll") for (int d = 0; d < 4; ++d) { \
            const bf16x8 vf = *(const LAS bf16x8*)(Vp + d * 32 * 144 + s4 * 32); o[d] = __builtin_amdgcn_mfma_f32_32x32x16_bf16(vf, pf[s4], o[d], 0, 0, 0); } } while (0)
#define ATT_RESC() do { if (pend) { _Pragma("unroll") for (int d = 0; d < 4; ++d) _Pragma("unroll") for (int r = 0; r < 16; ++r) o[d][r] *= alpha_pend; } } while (0)
    ATT_LOADK(1); ATT_LOADV(0);
    ATT_QK(0); ATT_CHECK(true); ATT_EXPSUM(); ATT_PACK();
    ATT_STOREK(1); ATT_STOREV(0);
    __syncthreads();
    for (int t = 1; t < ntiles; ++t) {
        if (t + 1 < ntiles) ATT_LOADK(t + 1);
        ATT_LOADV(t);
        ATT_QK(t);
        ATT_CHECK(false);
        __builtin_amdgcn_sched_barrier(0);
        { bf16x8 pfo[4] = {pf[0], pf[1], pf[2], pf[3]};
          const LAS unsigned char* Vp = lds + 2 * AKB + ((t - 1) & 1) * AVB + r32 * 144 + hi * 16;
          float ps = 0.f;
#pragma unroll
          for (int s4 = 0; s4 < 4; ++s4) {
#pragma unroll
              for (int d = 0; d < 4; ++d) { const bf16x8 vf = *(const LAS bf16x8*)(Vp + d * 32 * 144 + s4 * 32); o[d] = __builtin_amdgcn_mfma_f32_32x32x16_bf16(vf, pfo[s4], o[d], 0, 0, 0); }
              if (s4 < 2) {
#pragma unroll
                  for (int r = 8 * s4; r < 8 * s4 + 8; ++r) { s0[r] = fast_exp2(s0[r] - mref); ps += s0[r]; }
              } else {
#pragma unroll
                  for (int r = 8 * (s4 - 2); r < 8 * (s4 - 2) + 8; ++r) { s1[r] = fast_exp2(s1[r] - mref); ps += s1[r]; }
              }
          }
          lsum += ps;
          asm volatile("" : "+v"(s0), "+v"(s1), "+v"(lsum));
          __builtin_amdgcn_sched_group_barrier(0x100, 4, 0);
#pragma unroll
          for (int i = 0; i < 16; ++i) { __builtin_amdgcn_sched_group_barrier(0x008, 1, 0); __builtin_amdgcn_sched_group_barrier(0x100, 1, 0); __builtin_amdgcn_sched_group_barrier(0x002, 6, 0); }
        }
        __builtin_amdgcn_sched_barrier(0);
        ATT_RESC();
        ATT_PACK();
        if (t + 1 < ntiles) ATT_STOREK(t + 1);
        ATT_STOREV(t);
        __syncthreads();
    }
    ATT_PV(ntiles - 1);
    __syncthreads();
#undef ATT_QK
#undef ATT_CHECK
#undef ATT_EXPSUM
#undef ATT_PACK
#undef ATT_PV
#undef ATT_RESC
#undef ATT_LOADK
#undef ATT_LOADV
#undef ATT_STOREK
#undef ATT_STOREV
    const float ltot = lsum + __shfl_xor(lsum, 32), inv = 1.0f / ltot;
    LAS float* X = (LAS float*)lds;
    if (mp == 1) {
#pragma unroll
        for (int d = 0; d < 4; ++d)
#pragma unroll
            for (int r = 0; r < 16; ++r) X[(qb * 64 + d * 16 + r) * 64 + lane] = o[d][r] * inv;
    }
    __syncthreads();
    if (mp == 0) {
        float ss = 0.f;
#pragma unroll
        for (int d = 0; d < 4; ++d)
#pragma unroll
            for (int r = 0; r < 16; ++r) { const float v = o[d][r] * inv - a.lam * X[(qb * 64 + d * 16 + r) * 64 + lane]; o[d][r] = v; ss += v * v; }
        ss += __shfl_xor(ss, 32);
        const float rn = a.oscale / sqrtf(ss * (1.0f / 128.0f) + EPS);
        bf16_t* op = a.O + (size_t)(qrow0 + qb * 32 + r32) * 512 + h * 128 + 4 * hi;
#pragma unroll
        for (int d = 0; d < 4; ++d)
#pragma unroll
            for (int g4 = 0; g4 < 4; ++g4) { const f32x4 gv = *(const f32x4*)(a.subln + d * 32 + 8 * g4 + 4 * hi);
                u32x2 w; w.x = pk2(o[d][4 * g4] * rn * gv.x, o[d][4 * g4 + 1] * rn * gv.y); w.y = pk2(o[d][4 * g4 + 2] * rn * gv.z, o[d][4 * g4 + 3] * rn * gv.w);
                *(u32x2*)(op + d * 32 + 8 * g4) = w; }
    }
    __syncthreads();
}
__device__ __forceinline__ void sg_unit(LAS unsigned char* lds, int R0, const bf16_t* SV, bf16_t* U, const float* ng, const bf16_t* sgw, const float* sgb, int tid, int wid, int lane) {
    LAS float* st = (LAS float*)(lds + 139264);
    { u32x4 xs[16];
#pragma unroll
      for (int i = 0; i < 16; ++i) xs[i] = *(const u32x4*)(SV + (size_t)(R0 + wid * 16 + i) * 512 + lane * 8);
#pragma unroll
      for (int i = 0; i < 16; ++i) { const int row = wid * 16 + i; const u32x4 x = xs[i];
        const float f0 = bflo(x.x), f1 = bfhi(x.x), f2 = bflo(x.y), f3 = bfhi(x.y), f4 = bflo(x.z), f5 = bfhi(x.z), f6 = bflo(x.w), f7 = bfhi(x.w);
        const float mean = wave_sum(((f0 + f1) + (f2 + f3)) + ((f4 + f5) + (f6 + f7))) * (1.0f / 512.0f);
        const float d0 = f0 - mean, d1 = f1 - mean, d2 = f2 - mean, d3 = f3 - mean, d4 = f4 - mean, d5 = f5 - mean, d6 = f6 - mean, d7 = f7 - mean;
        const float var = wave_sum(((d0 * d0 + d1 * d1) + (d2 * d2 + d3 * d3)) + ((d4 * d4 + d5 * d5) + (d6 * d6 + d7 * d7))) * (1.0f / 512.0f);
        if (lane == 0) { st[row * 2] = mean; st[row * 2 + 1] = 1.0f / sqrtf(var + EPS); } } }
    __syncthreads();
    { const f32x4 sv = *(const LAS f32x4*)(st + lane * 4);
      u32x4 xa[8], xb[8];
#pragma unroll
      for (int t = 0; t < 8; ++t) { xa[t] = *(const u32x4*)(SV + (size_t)(R0 + 2 * lane) * 512 + (wid * 8 + t) * 8); xb[t] = *(const u32x4*)(SV + (size_t)(R0 + 2 * lane + 1) * 512 + (wid * 8 + t) * 8); }
#pragma unroll
      for (int t = 0; t < 8; ++t) { const int cb = wid * 8 + t;
        const u32x4 x0 = xa[t], x1 = xb[t];
        const f32x4 g0 = *(const f32x4*)(ng + cb * 8), g1 = *(const f32x4*)(ng + cb * 8 + 4);
        LAS unsigned char* wp = lds + (cb * 8) * 272 + lane * 4;
        *(LAS unsigned*)(wp + 0 * 272) = pk2((bflo(x0.x) - sv.x) * sv.y * g0.x, (bflo(x1.x) - sv.z) * sv.w * g0.x);
        *(LAS unsigned*)(wp + 1 * 272) = pk2((bfhi(x0.x) - sv.x) * sv.y * g0.y, (bfhi(x1.x) - sv.z) * sv.w * g0.y);
        *(LAS unsigned*)(wp + 2 * 272) = pk2((bflo(x0.y) - sv.x) * sv.y * g0.z, (bflo(x1.y) - sv.z) * sv.w * g0.z);
        *(LAS unsigned*)(wp + 3 * 272) = pk2((bfhi(x0.y) - sv.x) * sv.y * g0.w, (bfhi(x1.y) - sv.z) * sv.w * g0.w);
        *(LAS unsigned*)(wp + 4 * 272) = pk2((bflo(x0.z) - sv.x) * sv.y * g1.x, (bflo(x1.z) - sv.z) * sv.w * g1.x);
        *(LAS unsigned*)(wp + 5 * 272) = pk2((bfhi(x0.z) - sv.x) * sv.y * g1.y, (bfhi(x1.z) - sv.z) * sv.w * g1.y);
        *(LAS unsigned*)(wp + 6 * 272) = pk2((bflo(x0.w) - sv.x) * sv.y * g1.z, (bflo(x1.w) - sv.z) * sv.w * g1.z);
        *(LAS unsigned*)(wp + 7 * 272) = pk2((bfhi(x0.w) - sv.x) * sv.y * g1.w, (bfhi(x1.w) - sv.z) * sv.w * g1.w); } }
    __syncthreads();
    { const int g = wid >> 1, ph = wid & 1, r32 = lane & 31, hi = lane >> 5;
      for (int pbi = 0; pbi < 2; ++pbi) { const int pcol = (ph * 2 + pbi) * 32 + r32;
        f32x16 acc[4];
#pragma unroll
        for (int d = 0; d < 4; ++d)
#pragma unroll
            for (int r = 0; r < 16; ++r) acc[d][r] = 0.f;
        const bf16_t* wrow = sgw + ((size_t)g * 128 + pcol) * 128 + hi * 8;
        const LAS unsigned char* ap = lds + (g * 128 + r32) * 272 + hi * 16;
#pragma unroll
        for (int ks = 0; ks < 8; ++ks) { const bf16x8 bf = *(const bf16x8*)(wrow + ks * 16);
#pragma unroll
            for (int d = 0; d < 4; ++d) { const bf16x8 af = *(const LAS bf16x8*)(ap + d * 32 * 272 + ks * 32); acc[d] = __builtin_amdgcn_mfma_f32_32x32x16_bf16(af, bf, acc[d], 0, 0, 0); } }
        const float bias = sgb[g * 128 + pcol];
        bf16_t* up = U + (size_t)(R0 + pcol) * 512 + g * 128 + 4 * hi;
#pragma unroll
        for (int d = 0; d < 4; ++d)
#pragma unroll
            for (int g4 = 0; g4 < 4; ++g4) { const u32x2 uu = *(const u32x2*)(up + d * 32 + 8 * g4);
                u32x2 w; w.x = pk2(bflo(uu.x) * (acc[d][4 * g4] + bias), bfhi(uu.x) * (acc[d][4 * g4 + 1] + bias)); w.y = pk2(bflo(uu.y) * (acc[d][4 * g4 + 2] + bias), bfhi(uu.y) * (acc[d][4 * g4 + 3] + bias));
                *(u32x2*)(up + d * 32 + 8 * g4) = w; } } }
    __syncthreads();
}
__device__ __forceinline__ void mixer_phase(const Params& p, int layer, bool last, LAS unsigned char* lds, int tid, int wid, int lane) {
    AttnArgs a; a.Q = (const bf16_t*)(p.ws + WS_Q); a.K = (const bf16_t*)(p.ws + WS_K); a.VT = (const bf16_t*)(p.ws + WS_VT); a.O = (bf16_t*)(p.ws + WS_O);
    a.subln = p.in[12] + layer * 128; a.lam = ((const float*)(p.ws + WS_LAM))[layer]; a.oscale = 1.0f - ((const LAS float*)(lds + 143360 + 200))[layer];
    const int n_ctx_att = last ? 0 : 128, n_sg = last ? 256 : 288, n_items = 1024 + n_ctx_att + n_sg, G = gridDim.x;
    for (int rep = 0; rep < (DUP_ATTN ? 2 : 1); ++rep)
    for (int it = blockIdx.x; it < (rep == 0 ? n_items : 1024); it += G) {
        if (it < 1024) {
            int bh, qblk;
            if (G == 256) { const int c = it & 255, round = it >> 8, x = c & 7, slot = c >> 3; bh = round * 16 + x * 2 + (slot >> 4); qblk = slot & 15; } else { bh = it >> 4; qblk = it & 15; }
            attn_unit(lds, a, bh >> 2, bh & 3, (bh >> 2) * SEQ + qblk * 128, 36, tid, wid, lane);
        } else if (it < 1024 + n_ctx_att) { const int r = it - 1024, bh = r >> 1, half = r & 1;
            attn_unit(lds, a, bh >> 2, bh & 3, RL + (bh >> 2) * CTXL + half * 128, 4, tid, wid, lane);
        } else { const int n = it - 1024 - n_ctx_att;
            sg_unit(lds, n * 128, (const bf16_t*)(p.ws + WS_SV), (bf16_t*)(p.ws + WS_U), p.in[13] + layer * 512, (const bf16_t*)(p.ws + WS_SGW) + (size_t)layer * 4 * 128 * 128, p.in[15] + layer * 512, tid, wid, lane);
        }
    }
}
__device__ __forceinline__ void final_phase(const Params& p, int wid, int lane) {
    const float* g = p.in[22]; const int gw = blockIdx.x * 8 + wid, NGW = gridDim.x * 8;
    for (int r = gw; r < RL; r += NGW) { float* xr = p.out + (size_t)r * DM;
        f32x4 v[4]; float ss = 0.f;
#pragma unroll
        for (int j = 0; j < 4; ++j) { v[j] = ((const f32x4*)xr)[lane + 64 * j]; ss += (v[j].x * v[j].x + v[j].y * v[j].y) + (v[j].z * v[j].z + v[j].w * v[j].w); }
        const float rstd = 1.0f / sqrtf(wave_sum(ss) * (1.0f / DM) + EPS);
#pragma unroll
        for (int j = 0; j < 4; ++j) ((f32x4*)xr)[lane + 64 * j] = (v[j] * rstd) * ((const f32x4*)g)[lane + 64 * j]; }
}

typedef unsigned gu32_unused_t;
#define RLX_AGENT __ATOMIC_RELAXED, __HIP_MEMORY_SCOPE_AGENT
#define XB_TMO      128
#define XB_XCNT(j)  (256  + 64 * (j))
#define XB_XSUB(j)  (1280 + 64 * (j))
#define XB_XGEN(j)  (2304 + 64 * (j))
#define XB_TOP      3328
#define XB_TOPGEN   3392
#define XCD_BAR_WORDS 3456
#define XB_SPIN_CAP (1u << 18)

__device__ __forceinline__ unsigned xb_ld(unsigned* p)              { return __hip_atomic_load(p, __ATOMIC_RELAXED, __HIP_MEMORY_SCOPE_AGENT); }
__device__ __forceinline__ unsigned xb_add(unsigned* p, unsigned v) { return __hip_atomic_fetch_add(p, v, __ATOMIC_RELAXED, __HIP_MEMORY_SCOPE_AGENT); }
__device__ __forceinline__ unsigned xb_xcc_id() { return (unsigned)__builtin_amdgcn_s_getreg((3 << 11) | 20) & 0xFu; }
#define XB_SPIN(cond, bar) do { unsigned _sp = 0; while (cond) { __builtin_amdgcn_s_sleep(1); \
    if ((++_sp & 255u) == 0u) { if (xb_ld(&(bar)[XB_TMO])) break; if (_sp > XB_SPIN_CAP) { atomicAdd(&(bar)[XB_TMO], 1u); break; } } } } while (0)
struct XcdBarrier {
    unsigned* bar; unsigned x;
    volatile LAS unsigned* st;
};

__device__ __forceinline__ XcdBarrier xcd_barrier_post(unsigned* bar, volatile LAS unsigned* st) {
    XcdBarrier b; b.bar = bar; b.x = xb_xcc_id(); b.st = st;
    if (threadIdx.x == 0) (void)xb_add(&bar[XB_XCNT(b.x)], 1u);
    return b;
}
__device__ __forceinline__ void xcd_barrier_complete(unsigned* bar, unsigned x, unsigned& nloc, unsigned& nx) {
    const unsigned G = gridDim.x * gridDim.y * gridDim.z;
    unsigned sum, cnt, mine, sp = 0u;
    for (;;) {
        sum = 0u; cnt = 0u; mine = 0u;
#pragma unroll
        for (unsigned j = 0; j < 16; ++j) { const unsigned c = xb_ld(&bar[XB_XCNT(j)]); sum += c; cnt += (c > 0u) ? 1u : 0u; mine = (j == x) ? c : mine; }
        if (sum == G) break;
        __builtin_amdgcn_s_sleep(1);
        if ((++sp & 255u) == 0u) { if (xb_ld(&bar[XB_TMO])) break; if (sp > XB_SPIN_CAP) { atomicAdd(&bar[XB_TMO], 1u); break; } }
    }
    nloc = mine > 0u ? mine : 1u; nx = cnt > 0u ? cnt : 1u;
}

__device__ __forceinline__ void xcd_barrier(const XcdBarrier& b) {
    asm volatile("s_waitcnt vmcnt(0)" ::: "memory");
    __syncthreads();
    if (threadIdx.x == 0) {
        unsigned* bar = b.bar;
        __builtin_amdgcn_s_waitcnt(0);
        unsigned nloc = b.st[0], nx = b.st[1];
        if (nloc == 0u) { xcd_barrier_complete(bar, b.x, nloc, nx); b.st[0] = nloc; b.st[1] = nx; }
        const unsigned old = xb_add(&bar[XB_XSUB(b.x)], 1u);
        const unsigned gen = old / nloc;
        if (old + 1u == (gen + 1u) * nloc) {
            __builtin_amdgcn_fence(__ATOMIC_RELEASE, "agent");
            asm volatile("s_waitcnt vmcnt(0)" ::: "memory");
            const unsigned og = xb_add(&bar[XB_TOP], 1u);
            const unsigned tg = og / nx;
            if (og + 1u == (tg + 1u) * nx) xb_add(&bar[XB_TOPGEN], 1u);
            else XB_SPIN(xb_ld(&bar[XB_TOPGEN]) == tg, bar);
            __builtin_amdgcn_fence(__ATOMIC_ACQUIRE, "agent");
            xb_add(&bar[XB_XGEN(b.x)], 1u);
            asm volatile("s_waitcnt vmcnt(0)" ::: "memory");
        } else {
            XB_SPIN(xb_ld(&bar[XB_XGEN(b.x)]) == gen, bar);
            __builtin_amdgcn_fence(__ATOMIC_ACQUIRE, "agent");
            asm volatile("s_waitcnt vmcnt(0)" ::: "memory");
        }
    }
    __syncthreads();
}

constexpr int LDSP_OFF = 143360;
__device__ __forceinline__ unsigned long long ldsp64(LAS const unsigned* P, int i) {
    const unsigned lo = __builtin_amdgcn_readfirstlane(P[2 * i]), hi = __builtin_amdgcn_readfirstlane(P[2 * i + 1]); return ((unsigned long long)hi << 32) | lo; }
__device__ __forceinline__ Params load_params(LAS unsigned char* lds) {
    LAS const unsigned* P = (LAS const unsigned*)(lds + LDSP_OFF);
    Params q;
    q.in[0] = (const float*)(const __attribute__((address_space(1))) float*)ldsp64(P, 0);
    q.in[1] = (const float*)(const __attribute__((address_space(1))) float*)ldsp64(P, 1);
    q.in[2] = (const float*)(const __attribute__((address_space(1))) float*)ldsp64(P, 2);
    q.in[3] = (const float*)(const __attribute__((address_space(1))) float*)ldsp64(P, 3);
    q.in[4] = (const float*)(const __attribute__((address_space(1))) float*)ldsp64(P, 4);
    q.in[5] = (const float*)(const __attribute__((address_space(1))) float*)ldsp64(P, 5);
    q.in[6] = (const float*)(const __attribute__((address_space(1))) float*)ldsp64(P, 6);
    q.in[7] = (const float*)(const __attribute__((address_space(1))) float*)ldsp64(P, 7);
    q.in[8] = (const float*)(const __attribute__((address_space(1))) float*)ldsp64(P, 8);
    q.in[9] = (const float*)(const __attribute__((address_space(1))) float*)ldsp64(P, 9);
    q.in[10] = (const float*)(const __attribute__((address_space(1))) float*)ldsp64(P, 10);
    q.in[11] = (const float*)(const __attribute__((address_space(1))) float*)ldsp64(P, 11);
    q.in[12] = (const float*)(const __attribute__((address_space(1))) float*)ldsp64(P, 12);
    q.in[13] = (const float*)(const __attribute__((address_space(1))) float*)ldsp64(P, 13);
    q.in[14] = (const float*)(const __attribute__((address_space(1))) float*)ldsp64(P, 14);
    q.in[15] = (const float*)(const __attribute__((address_space(1))) float*)ldsp64(P, 15);
    q.in[16] = (const float*)(const __attribute__((address_space(1))) float*)ldsp64(P, 16);
    q.in[17] = (const float*)(const __attribute__((address_space(1))) float*)ldsp64(P, 17);
    q.in[18] = (const float*)(const __attribute__((address_space(1))) float*)ldsp64(P, 18);
    q.in[19] = (const float*)(const __attribute__((address_space(1))) float*)ldsp64(P, 19);
    q.in[20] = (const float*)(const __attribute__((address_space(1))) float*)ldsp64(P, 20);
    q.in[21] = (const float*)(const __attribute__((address_space(1))) float*)ldsp64(P, 21);
    q.in[22] = (const float*)(const __attribute__((address_space(1))) float*)ldsp64(P, 22);
    q.out = (float*)(__attribute__((address_space(1))) float*)ldsp64(P, 23); q.ws = (unsigned char*)(__attribute__((address_space(1))) unsigned char*)ldsp64(P, 24);
    q.lam_init[0] = __uint_as_float(__builtin_amdgcn_readfirstlane(P[50]));
    q.lam_init[1] = __uint_as_float(__builtin_amdgcn_readfirstlane(P[51]));
    q.lam_init[2] = __uint_as_float(__builtin_amdgcn_readfirstlane(P[52]));
    q.lam_init[3] = __uint_as_float(__builtin_amdgcn_readfirstlane(P[53]));
    q.lo = 0; q.hi = 0;
    return q;
}
__global__ void __launch_bounds__(512) fwd_kernel(Params kp) {
    extern __shared__ __attribute__((aligned(16))) unsigned char lds_raw[];
    LAS unsigned char* lds = (LAS unsigned char*)lds_raw;
    const int G = gridDim.x, lo = kp.lo, hi = kp.hi;
    if (threadIdx.x == 0) { LAS unsigned long long* P = (LAS unsigned long long*)(lds + LDSP_OFF);
        P[0] = (unsigned long long)kp.in[0];
        P[1] = (unsigned long long)kp.in[1];
        P[2] = (unsigned long long)kp.in[2];
        P[3] = (unsigned long long)kp.in[3];
        P[4] = (unsigned long long)kp.in[4];
        P[5] = (unsigned long long)kp.in[5];
        P[6] = (unsigned long long)kp.in[6];
        P[7] = (unsigned long long)kp.in[7];
        P[8] = (unsigned long long)kp.in[8];
        P[9] = (unsigned long long)kp.in[9];
        P[10] = (unsigned long long)kp.in[10];
        P[11] = (unsigned long long)kp.in[11];
        P[12] = (unsigned long long)kp.in[12];
        P[13] = (unsigned long long)kp.in[13];
        P[14] = (unsigned long long)kp.in[14];
        P[15] = (unsigned long long)kp.in[15];
        P[16] = (unsigned long long)kp.in[16];
        P[17] = (unsigned long long)kp.in[17];
        P[18] = (unsigned long long)kp.in[18];
        P[19] = (unsigned long long)kp.in[19];
        P[20] = (unsigned long long)kp.in[20];
        P[21] = (unsigned long long)kp.in[21];
        P[22] = (unsigned long long)kp.in[22];
        P[23] = (unsigned long long)kp.out; P[24] = (unsigned long long)kp.ws;
        LAS float* Pf = (LAS float*)(lds + LDSP_OFF + 200);
        Pf[0] = kp.lam_init[0]; Pf[1] = kp.lam_init[1]; Pf[2] = kp.lam_init[2]; Pf[3] = kp.lam_init[3];
        volatile LAS unsigned* st = (volatile LAS unsigned*)(lds + LDSP_OFF + 256); st[0] = 0u; st[1] = 0u; }
    __syncthreads();
    if (hi - lo > 2) { const XcdBarrier b0 = xcd_barrier_post((unsigned*)kp.ws, (volatile LAS unsigned*)(lds + LDSP_OFF + 256)); if (threadIdx.x == 0) ((volatile LAS unsigned*)(lds + LDSP_OFF + 256))[2] = b0.x; }
    __syncthreads();
#define FRESH() int tid = threadIdx.x; asm volatile("" : "+v"(tid)); const int lane = tid & 63, wid = __builtin_amdgcn_readfirstlane(tid >> 6); (void)lane; (void)wid; (void)tid; const Params p = load_params(lds); unsigned char* ws = p.ws; (void)ws
    int ph = 0;
#ifndef PHM
#define PHM 0xffff
#endif
#define RUNS(k) ((k) >= lo && (k) < hi)
#define SEAM() do { if (RUNS(ph) && RUNS(ph + 1)) { if (ph == 0) cg::this_grid().sync(); else { XcdBarrier xb_; xb_.bar = (unsigned*)(__attribute__((address_space(1))) unsigned*)ldsp64((LAS const unsigned*)(lds + LDSP_OFF), 24); \
        xb_.x = ((volatile LAS unsigned*)(lds + LDSP_OFF + 256))[2]; xb_.st = (volatile LAS unsigned*)(lds + LDSP_OFF + 256); xcd_barrier(xb_); } } ++ph; } while (0)
    if ((PHM & 1) && RUNS(ph)) { FRESH(); prologue_phase(p, lds, tid, wid, lane); __syncthreads(); convert_layer_weights(p, 0, 0, CV_NIT, blockIdx.x * 8 + wid, gridDim.x * 8, lds, wid, lane); }
    SEAM();
    for (int layer = 0; layer < DEPTH; ++layer) {
        const bool last = layer == DEPTH - 1;
        const int M = last ? RL : RT;
        if ((PHM & 2) && RUNS(ph)) { FRESH(); if (layer > 0) convert_layer_weights(p, layer, G == 256 ? CV_NIT - CV_F2 : 0, CV_NIT, blockIdx.x * 8 + wid, G * 8, lds, wid, lane);
            norm_phase(p, layer, 0, RT, wid, lane); }
        SEAM();
        if ((PHM & 4) && RUNS(ph)) for (int rep = 0; rep < (DUP_GEMM ? 2 : 1); ++rep) { FRESH();
            EpiG1 E{(bf16_t*)(ws + WS_K), (bf16_t*)(ws + WS_VT), (bf16_t*)(ws + WS_Q), (bf16_t*)(ws + WS_U), (bf16_t*)(ws + WS_SV), (bf16_t*)(ws + WS_G), (const float*)(ws + WS_ROPE), 0};
            pg8::Gemm g{(const bf16_t*)(ws + WS_H), (const bf16_t*)(ws + WS_WIN), M, INW, DM}; pg8::StaticOrder S; S.init(M, INW, G, (int)blockIdx.x);
            pg8::gemm_phase<EpiG1, pg8::StaticOrder, true, true>(lds, g, S, E);
            if (last) {
                EpiG1 E2 = E; E2.row_off = RL;
                pg8::Gemm g2{(const bf16_t*)(ws + WS_H) + (size_t)RL * DM, (const bf16_t*)(ws + WS_WIN), RC, 1024, DM}; pg8::StaticOrder S2; S2.init(RC, 1024, G, (int)blockIdx.x);
                pg8::gemm_phase<EpiG1, pg8::StaticOrder, true, true>(lds, g2, S2, E2);
            }
        }
        SEAM();
        if ((PHM & 8) && RUNS(ph)) { FRESH(); mixer_phase(p, layer, last, lds, tid, wid, lane); }
        SEAM();
        if ((PHM & 16) && RUNS(ph)) for (int rep = 0; rep < (DUP_GEMM ? 2 : 1); ++rep) { FRESH();
            pg8::StaticOrder S; S.init(M, DM, G, (int)blockIdx.x);
            { EpiMerge<1> E{(const bf16_t*)(ws + WS_G), (bf16_t*)(ws + WS_H)}; pg8::Gemm g{(const bf16_t*)(ws + WS_O), (const bf16_t*)(ws + WS_WA), M, DM, 512};
              pg8::gemm_phase<EpiMerge<1>, pg8::StaticOrder, true, true>(lds, g, S, E); }
            { EpiMerge<2> E{(const bf16_t*)(ws + WS_G), (bf16_t*)(ws + WS_H)}; pg8::Gemm g{(const bf16_t*)(ws + WS_U), (const bf16_t*)(ws + WS_WSG), M, DM, 512};
              pg8::gemm_phase<EpiMerge<2>, pg8::StaticOrder, true, true>(lds, g, S, E); }
        }
        SEAM();
        if ((PHM & 32) && RUNS(ph)) { FRESH();
            const float* modl = (const float*)(ws + WS_MOD) + (size_t)layer * 17 * 6144;
            const float* xl_in = layer == 0 ? p.in[0] : p.out; const float* xc_in = layer == 0 ? p.in[2] : (const float*)(ws + WS_XC);
            EpiResid E{xl_in, xc_in, p.out, (float*)(ws + WS_XC), modl + 2 * DM};
            pg8::Gemm g{(const bf16_t*)(ws + WS_H), (const bf16_t*)(ws + WS_WO), M, DM, DM}; pg8::StaticOrder S; S.init(M, DM, G, (int)blockIdx.x);
            pg8::gemm_phase<EpiResid, pg8::StaticOrder, true, true>(lds, g, S, E);
        }
        SEAM();
        if ((PHM & 64) && RUNS(ph)) { FRESH(); norm_phase(p, layer, 1, M, wid, lane); }
        SEAM();
        if ((PHM & 128) && RUNS(ph)) for (int rep = 0; rep < (DUP_GEMM ? 2 : 1); ++rep) { FRESH();
            EpiFfn1 E{(bf16_t*)(ws + WS_ACT)};
            pg8::Gemm g{(const bf16_t*)(ws + WS_H), (const bf16_t*)(ws + WS_WF1), M, 2 * DFF, DM}; pg8::StaticOrder S; S.init(M, 2 * DFF, G, (int)blockIdx.x);
            pg8::gemm_phase<EpiFfn1, pg8::StaticOrder, true, true>(lds, g, S, E);
        }
        SEAM();
        if ((PHM & 256) && RUNS(ph)) { FRESH();
            const float* modl = (const float*)(ws + WS_MOD) + (size_t)layer * 17 * 6144;
            EpiResid E{p.out, (const float*)(ws + WS_XC), p.out, (float*)(ws + WS_XC), modl + 5 * DM};
            pg8::Gemm g{(const bf16_t*)(ws + WS_ACT), (const bf16_t*)(ws + WS_WF2), M, DM, DFF}; pg8::StaticOrder S; S.init(M, DM, G, (int)blockIdx.x);
            pg8::gemm_phase<EpiResid, pg8::StaticOrder, true, true>(lds, g, S, E);
            if (!last && G == 256 && blockIdx.x >= 64) convert_layer_weights(p, layer + 1, 0, CV_NIT - CV_F2, ((int)blockIdx.x - 64) * 8 + wid, 192 * 8, lds, wid, lane);
        }
        SEAM();
    }
    if ((PHM & 512) && RUNS(ph)) { FRESH(); final_phase(p, wid, lane); }
#undef RUNS
#undef SEAM
}

extern "C" void kernel_launch(void* const* d_in, const int* in_sizes, int n_in, void* d_out, int out_size, void* d_ws, size_t ws_size, hipStream_t stream) {
    static int grid = 0;
    if (grid == 0) {
        if (n_in != 23 || out_size != RL * DM || ws_size < WS_END) { fprintf(stderr, "kernel_launch: unexpected shapes (n_in %d out %d ws %zu)\n", n_in, out_size, ws_size); grid = -1; return; }
        int dev = 0, cus = 0, per_cu = 0;
        hipGetDevice(&dev); hipDeviceGetAttribute(&cus, hipDeviceAttributeMultiprocessorCount, dev);
        if (hipFuncSetAttribute((const void*)fwd_kernel, hipFuncAttributeMaxDynamicSharedMemorySize, LDS_BYTES) != hipSuccess) { fprintf(stderr, "kernel_launch: hipFuncSetAttribute failed\n"); grid = -1; return; }
        if (hipOccupancyMaxActiveBlocksPerMultiprocessor(&per_cu, (const void*)fwd_kernel, 512, LDS_BYTES) != hipSuccess || per_cu < 1) { fprintf(stderr, "kernel_launch: occupancy query says %d\n", per_cu); per_cu = 1; }
        (void)hipGetLastError();
        grid = cus * per_cu;
        if (grid > 256) grid = 256;
    }
    if (grid < 0) return;
    Params p{};
    for (int i = 0; i < 23; ++i) p.in[i] = (const float*)d_in[i];
    p.out = (float*)d_out; p.ws = (unsigned char*)d_ws;
    for (int i = 0; i < 4; ++i) p.lam_init[i] = (float)(0.8 - 0.6 * std::exp(-0.3 * (double)i));
#if COOP
    if (hipMemsetAsync(d_ws, 0, 16384, stream) != hipSuccess) { fprintf(stderr, "kernel_launch: memset of barrier words failed\n"); return; }
    p.lo = 0; p.hi = NPHASE;
    void* args[] = {&p};
    hipError_t e = hipLaunchCooperativeKernel((const void*)fwd_kernel, dim3(grid), dim3(512), args, LDS_BYTES, stream);
    if (e != hipSuccess) fprintf(stderr, "cooperative launch failed: %s (grid %d)\n", hipGetErrorString(e), grid);
#else
    for (int k = 0; k < NPHASE; ++k) { p.lo = k; p.hi = k + 1; hipLaunchKernelGGL(fwd_kernel, dim3(grid), dim3(512), LDS_BYTES, stream, p); }
#endif
}
```

```cpp
#include <hip/hip_runtime.h>
#include <hip/hip_cooperative_groups.h>
#include <cstdio>
#include <cstdint>
#include <cmath>
namespace cg = cooperative_groups;
#ifndef COOP
#define COOP 1
#endif
#ifndef DUP_GEMM
#define DUP_GEMM 0
#endif
#ifndef DUP_ATTN
#define DUP_ATTN 0
#endif
namespace pg8 {
#define PG8_LAS __attribute__((address_space(3)))
typedef unsigned short bf16_t;
typedef short bf16x8 __attribute__((ext_vector_type(8)));
typedef float f32x4 __attribute__((ext_vector_type(4)));
typedef unsigned u32x4 __attribute__((ext_vector_type(4)));
constexpr int BM = 256, BK = 64, HALF = 128, HTB = HALF * BK * 2  , STAGE_BYTES = 8 * HTB, NXCD = 8, WGM = 4;

__host__ __device__ __forceinline__ int lds_byte(int r, int c) { const int st = (r >> 4) * 2 + (c >> 5), rr = r & 15, cc = c & 31, ob = rr * 64 + cc * 2; return st * 1024 + (ob ^ (((ob >> 9) & 1) << 5)); }
__host__ __device__ __forceinline__ void stage_rc(int b, int& R, int& C) { const int st = b / 1024, sb = b % 1024, swz = sb ^ (((sb >> 9) & 1) << 5); R = (st >> 1) * 16 + swz / 64; C = (st & 1) * 32 + (swz % 64) / 2; }
__host__ __device__ __forceinline__ int perm32(int rho) { const int n = rho >> 4, i = rho & 15; return 8 * (i >> 2) + 4 * n + (i & 3); }

struct Unit { int pm, pn; };
struct Gemm { const bf16_t* A; const bf16_t* Bt; int M, N, K; };

struct StaticOrder {
    int nM, nN, nwg, G, c;
    __host__ __device__ void init(int M, int N, int G_, int c_) { nM = M / BM; nN = N / BM; nwg = nM * nN; G = G_; c = c_; }
    __host__ __device__ bool next(int i, Unit& u) const {
        const long L = (long)i * G + c; if (L >= nwg) return false;
        int wgid = (int)L; { const int q = nwg / NXCD, r = nwg % NXCD, xcd = wgid % NXCD, off = wgid / NXCD; wgid = (xcd < r ? xcd * (q + 1) : r * (q + 1) + (xcd - r) * q) + off; }
        const int nig = WGM * nN, gid = wgid / nig, fm = gid * WGM, gsz = (nM - fm) < WGM ? (nM - fm) : WGM;
        u.pm = fm + ((wgid % nig) % gsz); u.pn = (wgid % nig) / gsz; return true;
    }
    __device__ __forceinline__ void a_ready(const Unit&) const {}
    __device__ __forceinline__ void done(const Unit&) const {}
};

__device__ __forceinline__ unsigned cvt_pk_bf16(float lo, float hi) { unsigned r; asm volatile("v_cvt_pk_bf16_f32 %0, %1, %2" : "=v"(r) : "v"(lo), "v"(hi)); return r; }
typedef float f32x2 __attribute__((ext_vector_type(2)));
template <class Epi, class Sched, bool ALIGN_EPI = false, bool SP2 = false>
__device__ __forceinline__ void gemm_phase(PG8_LAS unsigned char* lds, const Gemm g, const Sched& S, const Epi& E) {
    int tid_ = threadIdx.x; asm volatile("" : "+v"(tid_));
    const int tid = tid_, wid = __builtin_amdgcn_readfirstlane(tid >> 6), lane = tid & 63, wr = wid >> 2, wc = wid & 3, fr = lane & 15, fq = lane >> 4;
    const int K = g.K, nt = K / BK;
    unsigned voffA[2], voffB[2];
#pragma unroll
    for (int i = 0; i < 2; ++i) { int R, C; stage_rc(tid * 16 + i * 8192, R, C); const int Rb = Epi::PERM ? ((R & ~31) + perm32(R & 31)) : R;
        voffA[i] = (unsigned)(R * K + C) * 2u; voffB[i] = (unsigned)(Rb * K + C) * 2u; }
    const size_t kstep = (size_t)(BK * 2);
    const size_t hstep = (size_t)HALF * K * 2;
    const size_t tstep = 2 * hstep;
    const unsigned ldsw = (unsigned)wid * 1024u;
    const int aoff = lds_byte(wr * 64 + fr, fq * 8), boff = lds_byte(wc * 32 + fr, fq * 8);
#define PG8_SA(b, h) (((b) * 2 + (h)) * HTB)
#define PG8_SB(b, h) ((4 + (b) * 2 + (h)) * HTB)
#define PG8_STAGE(bufoff, gbase, voff) do { _Pragma("unroll") for (int _i = 0; _i < 2; ++_i) \
        __builtin_amdgcn_global_load_lds((const unsigned*)((const char*)(gbase) + (voff)[_i]), (PG8_LAS unsigned*)(lds + (bufoff) + ldsw + _i * 8192), 16, 0, 0); } while (0)
#define PG8_LDA(dst, b, h) do { _Pragma("unroll") for (int m = 0; m < 4; ++m) _Pragma("unroll") for (int k = 0; k < 2; ++k) dst[m][k] = *(const PG8_LAS bf16x8*)(lds + PG8_SA(b, h) + aoff + m * 2048 + k * 1024); } while (0)
#define PG8_LDB(dst, b, h) do { _Pragma("unroll") for (int n = 0; n < 2; ++n) _Pragma("unroll") for (int k = 0; k < 2; ++k) dst[n][k] = *(const PG8_LAS bf16x8*)(lds + PG8_SB(b, h) + boff + n * 2048 + k * 1024); } while (0)
#define PG8_MMA(ai, bj, At, Bt) do { __builtin_amdgcn_s_setprio(1); _Pragma("unroll") for (int m = 0; m < 4; ++m) _Pragma("unroll") for (int n = 0; n < 2; ++n) _Pragma("unroll") for (int k = 0; k < 2; ++k) \
        acc[ai][bj][m][n] = __builtin_amdgcn_mfma_f32_16x16x32_bf16(Bt[n][k], At[m][k], acc[ai][bj][m][n], 0, 0, 0); __builtin_amdgcn_s_setprio(0); } while (0)
#define PG8_WAIT_V(n) asm volatile("s_waitcnt vmcnt(" #n ")" ::: "memory")
#define PG8_WAIT_L(n) asm volatile("s_waitcnt lgkmcnt(" #n ")" ::: "memory")
#define PG8_BAR __builtin_amdgcn_s_barrier()
#define PG8_SCHED __builtin_amdgcn_sched_barrier(0)
    Unit cur, nxt; int ui = 0;
    if (!S.next(0, cur)) return;
    f32x4 acc[2][2][4][2];
#pragma unroll
    for (int a = 0; a < 2; ++a)
#pragma unroll
        for (int b = 0; b < 2; ++b)
#pragma unroll
            for (int m = 0; m < 4; ++m)
#pragma unroll
                for (int n = 0; n < 2; ++n) acc[a][b][m][n] = (f32x4){0.f, 0.f, 0.f, 0.f};
    bf16x8 At[4][2], B0[2][2], B1[2][2];
    const char* cA = (const char*)g.A + (size_t)cur.pm * tstep; const char* cB = (const char*)g.Bt + (size_t)cur.pn * tstep;
    S.a_ready(cur);
    if constexpr (SP2) {
        PG8_STAGE(PG8_SB(0, 0), cB, voffB); PG8_STAGE(PG8_SB(0, 1), cB + hstep, voffB); PG8_STAGE(PG8_SA(0, 0), cA, voffA); PG8_STAGE(PG8_SA(0, 1), cA + hstep, voffA);
        if (wr == 1) PG8_BAR;
        PG8_WAIT_V(2); PG8_BAR;
        PG8_STAGE(PG8_SB(1, 0), cB + kstep, voffB); PG8_STAGE(PG8_SA(1, 0), cA + kstep, voffA); PG8_STAGE(PG8_SB(1, 1), cB + hstep + kstep, voffB);
        PG8_WAIT_V(6); PG8_BAR;
    } else {
        PG8_STAGE(PG8_SB(0, 0), cB, voffB); PG8_STAGE(PG8_SA(0, 0), cA, voffA); PG8_STAGE(PG8_SB(0, 1), cB + hstep, voffB); PG8_STAGE(PG8_SA(0, 1), cA + hstep, voffA);
        if (wr == 1) PG8_BAR;
        PG8_WAIT_V(4); PG8_BAR;
        PG8_STAGE(PG8_SB(1, 0), cB + kstep, voffB); PG8_STAGE(PG8_SA(1, 0), cA + kstep, voffA); PG8_STAGE(PG8_SB(1, 1), cB + hstep + kstep, voffB);
        PG8_WAIT_V(6); PG8_BAR;
    }
    for (;;) {
        const bool has_next = S.next(ui + 1, nxt);
        const char* nA = has_next ? (const char*)g.A + (size_t)nxt.pm * tstep : cA; const char* nB = has_next ? (const char*)g.Bt + (size_t)nxt.pn * tstep : cB;
        for (int t = 0; t < nt; t += 2) {
            const bool last = (t == nt - 2);
            const char* a1 = cA + (size_t)(t + 1) * kstep;
            const char* a2 = last ? nA : cA + (size_t)(t + 2) * kstep; const char* b2 = last ? nB : cB + (size_t)(t + 2) * kstep;
            const char* a3 = a2 + kstep; const char* b3 = b2 + kstep;
            if (last && has_next) S.a_ready(nxt);
            if constexpr (SP2) {
            PG8_LDB(B0, 0, 0); PG8_LDB(B1, 0, 1); PG8_SCHED; PG8_LDA(At, 0, 0); PG8_STAGE(PG8_SA(1, 1), a1 + hstep, voffA);
            PG8_WAIT_V(8); PG8_WAIT_L(0); PG8_BAR; PG8_MMA(0, 0, At, B0); PG8_MMA(0, 1, At, B1); PG8_BAR; PG8_SCHED;
            PG8_LDA(At, 0, 1); PG8_STAGE(PG8_SB(0, 0), b2, voffB); PG8_STAGE(PG8_SB(0, 1), b2 + hstep, voffB); PG8_STAGE(PG8_SA(0, 0), a2, voffA);
            PG8_WAIT_V(8); PG8_WAIT_L(0); PG8_BAR; PG8_MMA(1, 0, At, B0); PG8_MMA(1, 1, At, B1); PG8_BAR; PG8_SCHED;
            PG8_LDB(B0, 1, 0); PG8_LDB(B1, 1, 1); PG8_SCHED; PG8_LDA(At, 1, 0); PG8_STAGE(PG8_SA(0, 1), a2 + hstep, voffA);
            PG8_WAIT_V(8); PG8_WAIT_L(0); PG8_BAR; PG8_MMA(0, 0, At, B0); PG8_MMA(0, 1, At, B1); PG8_BAR; PG8_SCHED;
            PG8_LDA(At, 1, 1); PG8_STAGE(PG8_SB(1, 0), b3, voffB); PG8_STAGE(PG8_SB(1, 1), b3 + hstep, voffB); PG8_STAGE(PG8_SA(1, 0), a3, voffA);
            PG8_WAIT_V(8); PG8_WAIT_L(0); PG8_BAR; PG8_MMA(1, 0, At, B0); PG8_MMA(1, 1, At, B1); PG8_BAR; PG8_SCHED;
            } else {
            PG8_LDB(B0, 0, 0); PG8_SCHED; PG8_LDA(At, 0, 0); PG8_STAGE(PG8_SA(1, 1), a1 + hstep, voffA);
            PG8_WAIT_L(8); PG8_BAR; PG8_WAIT_L(0); PG8_MMA(0, 0, At, B0); PG8_BAR; PG8_SCHED;
            PG8_LDB(B1, 0, 1); PG8_STAGE(PG8_SB(0, 0), b2, voffB);
            PG8_BAR; PG8_WAIT_L(0); PG8_MMA(0, 1, At, B1); PG8_BAR;
            PG8_LDA(At, 0, 1); PG8_STAGE(PG8_SA(0, 0), a2, voffA);
            PG8_BAR; PG8_WAIT_L(0); PG8_MMA(1, 0, At, B0); PG8_BAR; PG8_SCHED;
            PG8_STAGE(PG8_SB(0, 1), b2 + hstep, voffB);
            PG8_WAIT_V(6); PG8_BAR; PG8_MMA(1, 1, At, B1); PG8_BAR;
            PG8_LDB(B0, 1, 0); PG8_SCHED; PG8_LDA(At, 1, 0); PG8_STAGE(PG8_SA(0, 1), a2 + hstep, voffA);
            PG8_WAIT_L(8); PG8_BAR; PG8_WAIT_L(0); PG8_MMA(0, 0, At, B0); PG8_BAR; PG8_SCHED;
            PG8_LDB(B1, 1, 1); PG8_STAGE(PG8_SB(1, 0), b3, voffB);
            PG8_BAR; PG8_WAIT_L(0); PG8_MMA(0, 1, At, B1); PG8_BAR;
            PG8_LDA(At, 1, 1); PG8_STAGE(PG8_SA(1, 0), a3, voffA);
            PG8_BAR; PG8_WAIT_L(0); PG8_MMA(1, 0, At, B0); PG8_BAR; PG8_SCHED;
            PG8_STAGE(PG8_SB(1, 1), b3 + hstep, voffB);
            PG8_WAIT_V(6); PG8_BAR; PG8_MMA(1, 1, At, B1); PG8_BAR;
            }
        }
        if constexpr (ALIGN_EPI) { if (wr == 0) PG8_BAR; }
        if constexpr (!Epi::AFTER_DRAIN) { E(acc, cur, wr, wc, fr, fq); S.done(cur); }
        if (!has_next) break;
#pragma unroll
        for (int a = 0; a < 2; ++a)
#pragma unroll
            for (int b = 0; b < 2; ++b)
#pragma unroll
                for (int m = 0; m < 4; ++m)
#pragma unroll
                    for (int n = 0; n < 2; ++n) acc[a][b][m][n] = (f32x4){0.f, 0.f, 0.f, 0.f};
        cur = nxt; cA = nA; cB = nB; ++ui;
        if constexpr (ALIGN_EPI) { if (wr == 1) PG8_BAR; }
    }
    PG8_WAIT_V(0);
    if constexpr (!ALIGN_EPI) { if (wr == 0) PG8_BAR; }
    PG8_BAR;
    if constexpr (Epi::AFTER_DRAIN) { E.fused(acc, cur, wr, wc, fr, fq, lds, wid, lane); S.done(cur); }
#undef PG8_SA
#undef PG8_SB
#undef PG8_STAGE
#undef PG8_LDA
#undef PG8_LDB
#undef PG8_MMA
#undef PG8_WAIT_V
#undef PG8_WAIT_L
#undef PG8_BAR
#undef PG8_SCHED
}
}

#define LAS __attribute__((address_space(3)))
using pg8::bf16_t; using pg8::bf16x8; using pg8::f32x4; using pg8::u32x4; using pg8::Unit;
typedef float f32x16 __attribute__((ext_vector_type(16)));
typedef unsigned u32x2 __attribute__((ext_vector_type(2)));
constexpr int DM = 1024, NB = 16, SEQ = 2048, CTXL = 256, DEPTH = 4;
constexpr int RL = NB * SEQ, RC = NB * CTXL, RT = RL + RC;
constexpr int INW = 4608, DFF = 2816, NKEYS = CTXL + SEQ;
constexpr float QSCALE = 0.125f * 1.4426950408889634f;
constexpr float EPS = 1e-6f;
constexpr size_t MiB = (size_t)1 << 20;
constexpr size_t WS_ROPE = 65536, WS_LAM = 131072, WS_MOD = 1 * MiB, WS_SGW = 3 * MiB;
constexpr size_t WS_WIN = 4 * MiB, WS_WA = 13 * MiB, WS_WSG = 14 * MiB, WS_WO = 15 * MiB, WS_WF1 = 17 * MiB, WS_WF2 = 28 * MiB;
constexpr size_t WS_XC = 34 * MiB, WS_H = 50 * MiB;
constexpr size_t WS_K = 122 * MiB, WS_VT = 158 * MiB, WS_Q = 194 * MiB, WS_U = 230 * MiB, WS_SV = 266 * MiB, WS_G = 302 * MiB, WS_ACT = 122 * MiB;
constexpr size_t WS_O = DUP_ATTN ? 446 * MiB : WS_Q;
constexpr size_t WS_END = (DUP_ATTN ? 482 : 446) * MiB;
constexpr int LDS_BYTES = 147456;
constexpr int NPHASE = 2 + 8 * DEPTH;

struct Params { const float* in[23]; float* out; unsigned char* ws; float lam_init[4]; int lo, hi; };

__device__ __forceinline__ float bf2f(unsigned short b) { return __uint_as_float((unsigned)b << 16); }
__device__ __forceinline__ float bflo(unsigned w) { return __uint_as_float(w << 16); }
__device__ __forceinline__ float bfhi(unsigned w) { return __uint_as_float(w & 0xffff0000u); }
__device__ __forceinline__ unsigned pk2(float lo, float hi) { return pg8::cvt_pk_bf16(lo, hi); }
__device__ __forceinline__ float fast_exp2(float x) { return __builtin_amdgcn_exp2f(x); }
__device__ __forceinline__ float fast_rcp(float x) { return __builtin_amdgcn_rcpf(x); }
__device__ __forceinline__ float sigmoidf_(float x) { return fast_rcp(1.0f + fast_exp2(-1.4426950408889634f * x)); }
__device__ __forceinline__ float siluf_(float x) { return x * sigmoidf_(x); }
__device__ __forceinline__ float geluf_(float x) { const float u = x * (0.7978845608028654f + 0.035677408136300125f * x * x); return x * fast_rcp(1.0f + fast_exp2(-2.8853900817779268f * u)); }
__device__ __forceinline__ float wave_sum(float v) {
#pragma unroll
    for (int o = 1; o < 64; o <<= 1) v += __shfl_xor(v, o);
    return v;
}
#define LDS_WAIT() asm volatile("s_waitcnt lgkmcnt(0)" ::: "memory")

struct EpiG1 {
    static constexpr bool PERM = true, AFTER_DRAIN = false;
    bf16_t *Kb, *VT, *Qb, *Ub, *SVb, *Gb; const float* rope; int row_off;
    __device__ __forceinline__ void operator()(const f32x4 (&acc)[2][2][4][2], const Unit& u, int wr, int wc, int fr, int fq) const {
        const int rbase = row_off + u.pm * 256 + wr * 64 + fr;
        const bool latent = (row_off + u.pm * 256) < RL;
        const int pn = u.pn, cw = wc * 32 + 8 * fq;
        if (pn >= 6) {
            const bool gate = pn >= 10;
            bf16_t* base; int ld;
            if (gate) { base = Gb + (pn - 10) * 256 + cw; ld = 2048; } else { base = (pn < 8 ? Ub : SVb) + (pn & 1) * 256 + cw; ld = 512; }
#pragma unroll
            for (int ai = 0; ai < 2; ++ai)
#pragma unroll
                for (int m = 0; m < 4; ++m) { bf16_t* rowp = base + (size_t)(rbase + ai * 128 + m * 16) * ld;
#pragma unroll
                    for (int bj = 0; bj < 2; ++bj) { const f32x4 v0 = acc[ai][bj][m][0], v1 = acc[ai][bj][m][1]; float y[8];
#pragma unroll
                        for (int j = 0; j < 4; ++j) { y[j] = gate ? sigmoidf_(v0[j]) : geluf_(v0[j]); y[4 + j] = gate ? sigmoidf_(v1[j]) : geluf_(v1[j]); }
                        u32x4 w; w.x = pk2(y[0], y[1]); w.y = pk2(y[2], y[3]); w.z = pk2(y[4], y[5]); w.w = pk2(y[6], y[7]);
                        *(u32x4*)(rowp + bj * 128) = w; } }
        } else if (pn == 2 || pn == 3) {
#pragma unroll
            for (int ai = 0; ai < 2; ++ai)
#pragma unroll
                for (int m = 0; m < 4; ++m) { const int row = rbase + ai * 128 + m * 16; int b, key;
                    if (latent) { b = row >> 11; key = CTXL + (row & 2047); } else { const int rc = row - RL; b = rc >> 8; key = rc & 255; }
                    const int pos = (key & ~12) | ((key & 4) << 1) | ((key & 8) >> 1);
#pragma unroll
                    for (int bj = 0; bj < 2; ++bj) { const int head = (pn & 1) * 2 + bj; bf16_t* p = VT + ((size_t)((b * 4 + head) * 128 + cw)) * NKEYS + pos;
                        const f32x4 v0 = acc[ai][bj][m][0], v1 = acc[ai][bj][m][1];
                        const unsigned w0 = pk2(v0[0], v0[1]), w1 = pk2(v0[2], v0[3]), w2 = pk2(v1[0], v1[1]), w3 = pk2(v1[2], v1[3]);
                        p[0 * NKEYS] = (bf16_t)(w0 & 0xffff); p[1 * NKEYS] = (bf16_t)(w0 >> 16); p[2 * NKEYS] = (bf16_t)(w1 & 0xffff); p[3 * NKEYS] = (bf16_t)(w1 >> 16);
                        p[4 * NKEYS] = (bf16_t)(w2 & 0xffff); p[5 * NKEYS] = (bf16_t)(w2 >> 16); p[6 * NKEYS] = (bf16_t)(w3 & 0xffff); p[7 * NKEYS] = (bf16_t)(w3 >> 16); } }
        } else {
            const bool isq = pn >= 4; bf16_t* base = (isq ? Qb : Kb) + (pn & 1) * 256 + cw; const float sc = isq ? QSCALE : 1.0f;
#pragma unroll
            for (int ai = 0; ai < 2; ++ai)
#pragma unroll
                for (int m = 0; m < 4; ++m) { const int row = rbase + ai * 128 + m * 16;
                    f32x4 cs = (f32x4){1.f, 1.f, 1.f, 1.f}, sn = (f32x4){0.f, 0.f, 0.f, 0.f};
                    if (latent) { const int s = row & 2047, pos = (wc & 1) ? (s & 63) : (s >> 6); cs = *(const f32x4*)(rope + pos * 32 + 4 * fq); sn = *(const f32x4*)(rope + pos * 32 + 16 + 4 * fq); }
                    cs = cs * sc; sn = sn * sc;
#pragma unroll
                    for (int bj = 0; bj < 2; ++bj) { const f32x4 v0 = acc[ai][bj][m][0], v1 = acc[ai][bj][m][1]; u32x4 w;
                        w.x = pk2(v0[0] * cs[0] - v0[1] * sn[0], v0[1] * cs[0] + v0[0] * sn[0]);
                        w.y = pk2(v0[2] * cs[1] - v0[3] * sn[1], v0[3] * cs[1] + v0[2] * sn[1]);
                        w.z = pk2(v1[0] * cs[2] - v1[1] * sn[2], v1[1] * cs[2] + v1[0] * sn[2]);
                        w.w = pk2(v1[2] * cs[3] - v1[3] * sn[3], v1[3] * cs[3] + v1[2] * sn[3]);
                        *(u32x4*)(base + (size_t)row * 512 + bj * 128) = w; } }
        }
    }
};
template <int STEP> struct EpiMerge {
    static constexpr bool PERM = true, AFTER_DRAIN = false;
    const bf16_t* Gb; bf16_t* Mb;
    __device__ __forceinline__ void operator()(const f32x4 (&acc)[2][2][4][2], const Unit& u, int wr, int wc, int fr, int fq) const {
        const int rbase = u.pm * 256 + wr * 64 + fr, col0 = u.pn * 256 + wc * 32 + 8 * fq;
#pragma unroll
        for (int ai = 0; ai < 2; ++ai)
#pragma unroll
            for (int m = 0; m < 4; ++m) { const size_t row = (size_t)(rbase + ai * 128 + m * 16);
#pragma unroll
                for (int bj = 0; bj < 2; ++bj) { const f32x4 v0 = acc[ai][bj][m][0], v1 = acc[ai][bj][m][1];
                    const u32x4 g = *(const u32x4*)(Gb + row * 2048 + (STEP - 1) * 1024 + col0 + bj * 128);
                    bf16_t* mp = Mb + row * 1024 + col0 + bj * 128; float y[8];
                    y[0] = bflo(g.x) * v0[0]; y[1] = bfhi(g.x) * v0[1]; y[2] = bflo(g.y) * v0[2]; y[3] = bfhi(g.y) * v0[3];
                    y[4] = bflo(g.z) * v1[0]; y[5] = bfhi(g.z) * v1[1]; y[6] = bflo(g.w) * v1[2]; y[7] = bfhi(g.w) * v1[3];
                    if (STEP == 2) { const u32x4 t = *(const u32x4*)mp;
                        y[0] += bflo(t.x); y[1] += bfhi(t.x); y[2] += bflo(t.y); y[3] += bfhi(t.y); y[4] += bflo(t.z); y[5] += bfhi(t.z); y[6] += bflo(t.w); y[7] += bfhi(t.w); }
                    u32x4 w; w.x = pk2(y[0], y[1]); w.y = pk2(y[2], y[3]); w.z = pk2(y[4], y[5]); w.w = pk2(y[6], y[7]);
                    *(u32x4*)mp = w; } }
    }
};
struct EpiResid {
    static constexpr bool PERM = false, AFTER_DRAIN = false;
    const float* base_l; const float* base_c; float* out_l; float* out_c; const float* gate;
    __device__ __forceinline__ void operator()(const f32x4 (&acc)[2][2][4][2], const Unit& u, int wr, int wc, int fr, int fq) const {
        const int row0 = u.pm * 256; const bool latent = row0 < RL;
        const float* gp = gate + (size_t)(latent ? (row0 >> 11) : 16) * 6144;
        const float* bp = latent ? base_l + (size_t)row0 * DM : base_c + (size_t)(row0 - RL) * DM;
        float* op = latent ? out_l + (size_t)row0 * DM : out_c + (size_t)(row0 - RL) * DM;
        const int col0 = u.pn * 256 + wc * 32 + 4 * fq;
        f32x4 gv[2][2];
#pragma unroll
        for (int bj = 0; bj < 2; ++bj)
#pragma unroll
            for (int n = 0; n < 2; ++n) gv[bj][n] = *(const f32x4*)(gp + col0 + bj * 128 + n * 16);
#pragma unroll
        for (int ai = 0; ai < 2; ++ai)
#pragma unroll
            for (int m = 0; m < 4; ++m) { const size_t off = (size_t)(wr * 64 + fr + ai * 128 + m * 16) * DM + col0;
#pragma unroll
                for (int bj = 0; bj < 2; ++bj)
#pragma unroll
                    for (int n = 0; n < 2; ++n) { const f32x4 b = *(const f32x4*)(bp + off + bj * 128 + n * 16); *(f32x4*)(op + off + bj * 128 + n * 16) = b + gv[bj][n] * acc[ai][bj][m][n]; } }
    }
};
struct EpiFfn1 {
    static constexpr bool PERM = true, AFTER_DRAIN = false;
    bf16_t* act;
    __device__ __forceinline__ void operator()(const f32x4 (&acc)[2][2][4][2], const Unit& u, int wr, int wc, int fr, int fq) const {
        const int rbase = u.pm * 256 + wr * 64 + fr, col0 = u.pn * 128 + wc * 32 + 8 * fq;
#pragma unroll
        for (int ai = 0; ai < 2; ++ai)
#pragma unroll
            for (int m = 0; m < 4; ++m) { const f32x4 a0 = acc[ai][0][m][0], a1 = acc[ai][0][m][1], b0 = acc[ai][1][m][0], b1 = acc[ai][1][m][1]; float y[8];
#pragma unroll
                for (int j = 0; j < 4; ++j) { y[j] = siluf_(a0[j]) * b0[j]; y[4 + j] = siluf_(a1[j]) * b1[j]; }
                u32x4 w; w.x = pk2(y[0], y[1]); w.y = pk2(y[2], y[3]); w.z = pk2(y[4], y[5]); w.w = pk2(y[6], y[7]);
                *(u32x4*)(act + (size_t)(rbase + ai * 128 + m * 16) * DFF + col0) = w; }
    }
};

template <int MODE> __device__ __forceinline__ void transpose_item(const float* W, int K, int N, bf16_t* WT, LAS float* scr, int item, int lane) {
    const int nblk = N / 32, kb = item / nblk, nb = item % nblk, k0 = 64 * kb, n0 = 32 * nb, i = lane & 31;
    int srccol;
    if (MODE == 1) { const bool qk = (n0 < 512) || (n0 >= 1024 && n0 < 1536); srccol = n0 + (qk ? ((i & 1) * 16 + (i >> 1)) : i); }
    else if (MODE == 2) { const int pn = nb >> 3, half = (nb >> 2) & 1, jb = nb & 3; srccol = half * DFF + 128 * pn + 32 * jb + i; }
    else srccol = n0 + i;
#pragma unroll 8
    for (int t = 0; t < 32; ++t) { const int kk = 2 * t + (lane >> 5); scr[kk * 33 + i] = W[(size_t)(k0 + kk) * N + srccol]; }
    LDS_WAIT();
    const int c = lane & 7;
#pragma unroll
    for (int j = 0; j < 4; ++j) { const int n = (lane >> 3) + 8 * j; const LAS float* s = scr + (8 * c) * 33 + n;
        u32x4 o; o.x = pk2(s[0 * 33], s[1 * 33]); o.y = pk2(s[2 * 33], s[3 * 33]); o.z = pk2(s[4 * 33], s[5 * 33]); o.w = pk2(s[6 * 33], s[7 * 33]);
        *(u32x4*)(WT + (size_t)(n0 + n) * K + k0 + 8 * c) = o; }
    LDS_WAIT();
}
constexpr int CV_IN = 16 * 144, CV_A = 8 * 32, CV_O = 16 * 32, CV_F1 = 16 * 176, CV_F2 = 44 * 32, CV_NIT = CV_IN + 2 * CV_A + CV_O + CV_F1 + CV_F2;
__device__ __forceinline__ void convert_layer_weights(const Params& p, int layer, int it_lo, int it_hi, int gw, int NGW, LAS unsigned char* lds, int wid, int lane) {
    LAS float* scr = (LAS float*)(lds + wid * 8448);
    unsigned char* ws = p.ws;
    const float* w_in = p.in[7] + (size_t)layer * DM * INW; const float* w_a = p.in[16] + (size_t)layer * 512 * DM; const float* w_sg = p.in[17] + (size_t)layer * 512 * DM;
    const float* w_o = p.in[18] + (size_t)layer * DM * DM; const float* w_f1 = p.in[20] + (size_t)layer * DM * 2 * DFF; const float* w_f2 = p.in[21] + (size_t)layer * DFF * DM;
    constexpr int I_IN = CV_IN, I_A = CV_A, I_O = CV_O, I_F1 = CV_F1;
    for (int it = it_lo + gw; it < it_hi; it += NGW) {
        int r = it;
        if (r < I_IN) { transpose_item<1>(w_in, DM, INW, (bf16_t*)(ws + WS_WIN), scr, r, lane); continue; } r -= I_IN;
        if (r < I_A) { transpose_item<0>(w_a, 512, DM, (bf16_t*)(ws + WS_WA), scr, r, lane); continue; } r -= I_A;
        if (r < I_A) { transpose_item<0>(w_sg, 512, DM, (bf16_t*)(ws + WS_WSG), scr, r, lane); continue; } r -= I_A;
        if (r < I_O) { transpose_item<0>(w_o, DM, DM, (bf16_t*)(ws + WS_WO), scr, r, lane); continue; } r -= I_O;
        if (r < I_F1) { transpose_item<2>(w_f1, DM, 2 * DFF, (bf16_t*)(ws + WS_WF1), scr, r, lane); continue; } r -= I_F1;
        transpose_item<0>(w_f2, DFF, DM, (bf16_t*)(ws + WS_WF2), scr, r, lane);
    }
}
__device__ __forceinline__ void norm_row(const float* xrow, bf16_t* hrow, const float* g, const float* sh, const float* sc, int lane) {
    f32x4 v[4]; float ss = 0.f;
#pragma unroll
    for (int j = 0; j < 4; ++j) { v[j] = ((const f32x4*)xrow)[lane + 64 * j]; ss += (v[j].x * v[j].x + v[j].y * v[j].y) + (v[j].z * v[j].z + v[j].w * v[j].w); }
    const float rstd = 1.0f / sqrtf(wave_sum(ss) * (1.0f / DM) + EPS);
#pragma unroll
    for (int j = 0; j < 4; ++j) { const f32x4 gg = ((const f32x4*)g)[lane + 64 * j], s1 = ((const f32x4*)sc)[lane + 64 * j], s0 = ((const f32x4*)sh)[lane + 64 * j];
        const f32x4 y = (v[j] * rstd) * gg * (s1 + 1.0f) + s0;
        u32x2 w; w.x = pk2(y.x, y.y); w.y = pk2(y.z, y.w); ((u32x2*)hrow)[lane + 64 * j] = w; }
}
__device__ __forceinline__ void norm_phase(const Params& p, int layer, int which  , int nrows, int wid, int lane) {
    const float* xl = (layer == 0 && which == 0) ? p.in[0] : p.out;
    const float* xc = (layer == 0 && which == 0) ? p.in[2] : (const float*)(p.ws + WS_XC);
    const float* g = (which == 0 ? p.in[6] : p.in[19]) + layer * DM;
    const float* mod = (const float*)(p.ws + WS_MOD) + (size_t)layer * 17 * 6144 + (which == 0 ? 0 : 3) * DM;
    bf16_t* H = (bf16_t*)(p.ws + WS_H);
    const int gw = blockIdx.x * 8 + wid, NGW = gridDim.x * 8;
    for (int r = gw; r < nrows; r += NGW) {
        const bool latent = r < RL; const int vec = latent ? (r >> 11) : 16;
        const float* xr = latent ? xl + (size_t)r * DM : xc + (size_t)(r - RL) * DM;
        norm_row(xr, H + (size_t)r * DM, g, mod + (size_t)vec * 6144, mod + (size_t)vec * 6144 + DM, lane);
    }
}
__device__ __forceinline__ void prologue_phase(const Params& p, LAS unsigned char* lds, int tid, int wid, int lane) {
    LAS float* sct = (LAS float*)lds;
    LAS float* red = (LAS float*)(lds + 81920);
    const float* c = p.in[1]; const float* cctx = p.in[3];
    for (int idx = tid; idx < 17 * 1024; idx += 512) { const int v = idx >> 10, k = idx & 1023; const float cv = (v < 16) ? c[v * 1024 + k] : cctx[k]; sct[k * 20 + v] = cv / (1.0f + expf(-cv)); }
    __syncthreads();
    float* mod = (float*)(p.ws + WS_MOD);
    for (int it = blockIdx.x; it < 4 * 96; it += gridDim.x) {
        const int layer = it / 96, nb = it % 96;
        const float* W = p.in[4] + (size_t)layer * DM * 6144 + nb * 64 + lane;
        float acc[17];
#pragma unroll
        for (int v = 0; v < 17; ++v) acc[v] = 0.f;
#pragma unroll 16
        for (int kk = 0; kk < 128; ++kk) { const int k = wid * 128 + kk; const float w = W[(size_t)k * 6144];
            const LAS f32x4* s4 = (const LAS f32x4*)(sct + k * 20);
            const f32x4 a = s4[0], b = s4[1], cc = s4[2], d = s4[3], e = s4[4];
            acc[0] += w * a.x; acc[1] += w * a.y; acc[2] += w * a.z; acc[3] += w * a.w; acc[4] += w * b.x; acc[5] += w * b.y; acc[6] += w * b.z; acc[7] += w * b.w;
            acc[8] += w * cc.x; acc[9] += w * cc.y; acc[10] += w * cc.z; acc[11] += w * cc.w; acc[12] += w * d.x; acc[13] += w * d.y; acc[14] += w * d.z; acc[15] += w * d.w; acc[16] += w * e.x; }
#pragma unroll
        for (int v = 0; v < 17; ++v) red[(wid * 17 + v) * 64 + lane] = acc[v];
        __syncthreads();
        for (int o = tid; o < 17 * 64; o += 512) { const int v = o >> 6, l = o & 63; float s = 0.f;
#pragma unroll
            for (int w = 0; w < 8; ++w) s += red[(w * 17 + v) * 64 + l];
            mod[((size_t)layer * 17 + v) * 6144 + nb * 64 + l] = s + p.in[5][layer * 6144 + nb * 64 + l]; }
        __syncthreads();
    }
    if (blockIdx.x == 0) {
        float* rope = (float*)(p.ws + WS_ROPE);
        for (int t = tid; t < 1024; t += 512) { const int pos = t >> 4, m = t & 15;
            double pw = 1.0; for (int i = 0; i < (m >> 2); ++i) pw *= 10.0;
            pw *= (m & 3) == 0 ? 1.0 : (m & 3) == 1 ? 1.7782794100389228 : (m & 3) == 2 ? 3.1622776601683795 : 5.623413251903491;
            const float inv = 1.0f / (float)pw; const float angf = (float)pos * inv;
            double a = (double)angf; const double twopi = 6.283185307179586476925286766559; a -= twopi * rint(a / twopi);
            double sn = 0.0, cs = 0.0, term = 1.0;
            for (int n = 0; n < 30; n += 2) { cs += ((n & 2) ? -term : term); term *= a / (double)(n + 1); sn += ((n & 2) ? -term : term); term *= a / (double)(n + 2); }
            rope[pos * 32 + m] = (float)cs; rope[pos * 32 + 16 + m] = (float)sn; }
    }
    if (blockIdx.x == 1 && wid < 4) {
        const float a = p.in[8][wid * 64 + lane] * p.in[9][wid * 64 + lane], b = p.in[10][wid * 64 + lane] * p.in[11][wid * 64 + lane];
        const float sa = wave_sum(a), sb = wave_sum(b);
        if (lane == 0) ((float*)(p.ws + WS_LAM))[wid] = expf(sa) - expf(sb) + ((const LAS float*)(lds + 143360 + 200))[wid];
    }
    { bf16_t* sgw = (bf16_t*)(p.ws + WS_SGW); const float* src = p.in[14];
      for (int i = blockIdx.x * 512 + tid; i < 4 * 4 * 128 * 128 / 2; i += gridDim.x * 512) ((unsigned*)sgw)[i] = pk2(src[2 * i], src[2 * i + 1]); }
}

struct AttnArgs { const bf16_t* Q; const bf16_t* K; const bf16_t* VT; bf16_t* O; const float* subln; float lam, oscale; };
constexpr int AKB = 64 * 272, AVB = 128 * 144;
__device__ __forceinline__ void attn_unit(LAS unsigned char* lds, const AttnArgs& a, int b, int h, int qrow0, int ntiles, int tid, int wid, int lane) {
    const int qb = wid >> 1, mp = wid & 1, r32 = lane & 31, hi = lane >> 5;
    const int kch = tid & 15, krow = tid >> 4, vch = tid & 7, vrow = tid >> 3;
    const bf16_t* kctx = a.K + (size_t)(RL + b * CTXL + krow) * 512 + h * 128 + kch * 8;
    const bf16_t* klat = a.K + (size_t)(b * SEQ + krow) * 512 + h * 128 + kch * 8;
    const bf16_t* vsrc = a.VT + ((size_t)((b * 4 + h) * 128 + vrow)) * NKEYS + vch * 8;
    u32x4 kr0, kr1, vr0, vr1;
#define ATT_LOADK(j) do { const bf16_t* kp_ = ((j) < 4) ? kctx + (size_t)(64 * (j)) * 512 : klat + (size_t)(64 * ((j) - 4)) * 512; kr0 = *(const u32x4*)kp_; kr1 = *(const u32x4*)(kp_ + 32 * 512); } while (0)
#define ATT_LOADV(j) do { vr0 = *(const u32x4*)(vsrc + 64 * (j)); vr1 = *(const u32x4*)(vsrc + (size_t)64 * NKEYS + 64 * (j)); } while (0)
#define ATT_STOREK(j) do { *(LAS u32x4*)(lds + ((j) & 1) * AKB + krow * 272 + kch * 16) = kr0; *(LAS u32x4*)(lds + ((j) & 1) * AKB + (krow + 32) * 272 + kch * 16) = kr1; } while (0)
#define ATT_STOREV(j) do { *(LAS u32x4*)(lds + 2 * AKB + ((j) & 1) * AVB + vrow * 144 + vch * 16) = vr0; *(LAS u32x4*)(lds + 2 * AKB + ((j) & 1) * AVB + (vrow + 64) * 144 + vch * 16) = vr1; } while (0)
    bf16x8 qf[4];
    { const bf16_t* qp = a.Q + (size_t)(qrow0 + qb * 32 + r32) * 512 + h * 128 + mp * 64 + hi * 8;
#pragma unroll
      for (int ks = 0; ks < 4; ++ks) qf[ks] = *(const bf16x8*)(qp + ks * 16); }
    ATT_LOADK(0); ATT_STOREK(0);
    __syncthreads();
    f32x16 o[4];
#pragma unroll
    for (int d = 0; d < 4; ++d)
#pragma unroll
        for (int r = 0; r < 16; ++r) o[d][r] = 0.f;
    float mref = 0.f, lsum = 0.f, alpha_pend = 1.f; bool pend = false; f32x16 s0, s1; bf16x8 pf[4];
    const f32x16 zero16 = {0.f, 0.f, 0.f, 0.f, 0.f, 0.f, 0.f, 0.f, 0.f, 0.f, 0.f, 0.f, 0.f, 0.f, 0.f, 0.f};
    constexpr float THR = 8.0f;
#define ATT_QK(t) do { const LAS unsigned char* Kp = lds + ((t) & 1) * AKB + r32 * 272 + (mp * 64 + hi * 8) * 2; \
        _Pragma("unroll") for (int ks = 0; ks < 4; ++ks) { \
            const bf16x8 k0 = *(const LAS bf16x8*)(Kp + ks * 32), k1 = *(const LAS bf16x8*)(Kp + 32 * 272 + ks * 32); \
            if (ks == 0) { s0 = __builtin_amdgcn_mfma_f32_32x32x16_bf16(k0, qf[0], zero16, 0, 0, 0); s1 = __builtin_amdgcn_mfma_f32_32x32x16_bf16(k1, qf[0], zero16, 0, 0, 0); } \
            else { s0 = __builtin_amdgcn_mfma_f32_32x32x16_bf16(k0, qf[ks], s0, 0, 0, 0); s1 = __builtin_amdgcn_mfma_f32_32x32x16_bf16(k1, qf[ks], s1, 0, 0, 0); } } } while (0)
#define ATT_CHECK(first) do { float mx = __builtin_fmaxf(__builtin_fmaxf(s0[0], s1[0]), s0[1]); \
        _Pragma("unroll") for (int r = 2; r < 16; r += 2) mx = __builtin_fmaxf(__builtin_fmaxf(mx, s0[r]), s0[r + 1]); \
        _Pragma("unroll") for (int r = 1; r < 16; r += 2) mx = __builtin_fmaxf(__builtin_fmaxf(mx, s1[r]), s1[(r + 1) & 15]); \
        pend = false; \
        if ((first) || __any(mx - mref > THR)) { mx = fmaxf(mx, __shfl_xor(mx, 32)); \
            const float nref = (first) ? mx : fmaxf(mx, mref); alpha_pend = fast_exp2(mref - nref); mref = nref; lsum *= alpha_pend; pend = !(first); } } while (0)
#define ATT_EXPSUM() do { float ps = 0.f; _Pragma("unroll") for (int r = 0; r < 16; ++r) { s0[r] = fast_exp2(s0[r] - mref); s1[r] = fast_exp2(s1[r] - mref); ps += s0[r] + s1[r]; } lsum += ps; } while (0)
#define ATT_PACK() do { u32x4 w; \
        w.x = pk2(s0[0], s0[1]); w.y = pk2(s0[2], s0[3]); w.z = pk2(s0[4], s0[5]); w.w = pk2(s0[6], s0[7]); pf[0] = __builtin_bit_cast(bf16x8, w); \
        w.x = pk2(s0[8], s0[9]); w.y = pk2(s0[10], s0[11]); w.z = pk2(s0[12], s0[13]); w.w = pk2(s0[14], s0[15]); pf[1] = __builtin_bit_cast(bf16x8, w); \
        w.x = pk2(s1[0], s1[1]); w.y = pk2(s1[2], s1[3]); w.z = pk2(s1[4], s1[5]); w.w = pk2(s1[6], s1[7]); pf[2] = __builtin_bit_cast(bf16x8, w); \
        w.x = pk2(s1[8], s1[9]); w.y = pk2(s1[10], s1[11]); w.z = pk2(s1[12], s1[13]); w.w = pk2(s1[14], s1[15]); pf[3] = __builtin_bit_cast(bf16x8, w); } while (0)
#define ATT_PV(t) do { const LAS unsigned char* Vp = lds + 2 * AKB + ((t) & 1) * AVB + r32 * 144 + hi * 16; \
        _Pragma("unroll") for (int s4 = 0; s4 < 4; ++s4) _Pragma("unroll") for (int d = 0; d < 4; ++d) { \
            const bf16x8 vf = *(const LAS bf16x8*)(Vp + d * 32 * 144 + s4 * 32); o[d] = __builtin_amdgcn_mfma_f32_32x32x16_bf16(vf, pf[s4], o[d], 0, 0, 0); } } while (0)
#define ATT_RESC() do { if (pend) { _Pragma("unroll") for (int d = 0; d < 4; ++d) _Pragma("unroll") for (int r = 0; r < 16; ++r) o[d][r] *= alpha_pend; } } while (0)
    ATT_LOADK(1); ATT_LOADV(0);
    ATT_QK(0); ATT_CHECK(true); ATT_EXPSUM(); ATT_PACK();
    ATT_STOREK(1); ATT_STOREV(0);
    __syncthreads();
    for (int t = 1; t < ntiles; ++t) {
        if (t + 1 < ntiles) ATT_LOADK(t + 1);
        ATT_LOADV(t);
        ATT_QK(t);
        ATT_CHECK(false);
        __builtin_amdgcn_sched_barrier(0);
        { bf16x8 pfo[4] = {pf[0], pf[1], pf[2], pf[3]};
          const LAS unsigned char* Vp = lds + 2 * AKB + ((t - 1) & 1) * AVB + r32 * 144 + hi * 16;
          float ps = 0.f;
#pragma unroll
          for (int s4 = 0; s4 < 4; ++s4) {
#pragma unroll
              for (int d = 0; d < 4; ++d) { const bf16x8 vf = *(const LAS bf16x8*)(Vp + d * 32 * 144 + s4 * 32); o[d] = __builtin_amdgcn_mfma_f32_32x32x16_bf16(vf, pfo[s4], o[d], 0, 0, 0); }
              if (s4 < 2) {
#pragma unroll
                  for (int r = 8 * s4; r < 8 * s4 + 8; ++r) { s0[r] = fast_exp2(s0[r] - mref); ps += s0[r]; }
              } else {
#pragma unroll
                  for (int r = 8 * (s4 - 2); r < 8 * (s4 - 2) + 8; ++r) { s1[r] = fast_exp2(s1[r] - mref); ps += s1[r]; }
              }
          }
          lsum += ps;
          asm volatile("" : "+v"(s0), "+v"(s1), "+v"(lsum));
          __builtin_amdgcn_sched_group_barrier(0x100, 4, 0);
#pragma unroll
          for (int i = 0; i < 16; ++i) { __builtin_amdgcn_sched_group_barrier(0x008, 1, 0); __builtin_amdgcn_sched_group_barrier(0x100, 1, 0); __builtin_amdgcn_sched_group_barrier(0x002, 6, 0); }
        }
        __builtin_amdgcn_sched_barrier(0);
        ATT_RESC();
        ATT_PACK();
        if (t + 1 < ntiles) ATT_STOREK(t + 1);
        ATT_STOREV(t);
        __syncthreads();
    }
    ATT_PV(ntiles - 1);
    __syncthreads();
#undef ATT_QK
#undef ATT_CHECK
#undef ATT_EXPSUM
#undef ATT_PACK
#undef ATT_PV
#undef ATT_RESC
#undef ATT_LOADK
#undef ATT_LOADV
#undef ATT_STOREK
#undef ATT_STOREV
    const float ltot = lsum + __shfl_xor(lsum, 32), inv = 1.0f / ltot;
    LAS float* X = (LAS float*)lds;
    if (mp == 1) {
#pragma unroll
        for (int d = 0; d < 4; ++d)
#pragma unroll
            for (int r = 0; r < 16; ++r) X[(qb * 64 + d * 16 + r) * 64 + lane] = o[d][r] * inv;
    }
    __syncthreads();
    if (mp == 0) {
        float ss = 0.f;
#pragma unroll
        for (int d = 0; d < 4; ++d)
#pragma unroll
            for (int r = 0; r < 16; ++r) { const float v = o[d][r] * inv - a.lam * X[(qb * 64 + d * 16 + r) * 64 + lane]; o[d][r] = v; ss += v * v; }
        ss += __shfl_xor(ss, 32);
        const float rn = a.oscale / sqrtf(ss * (1.0f / 128.0f) + EPS);
        bf16_t* op = a.O + (size_t)(qrow0 + qb * 32 + r32) * 512 + h * 128 + 4 * hi;
#pragma unroll
        for (int d = 0; d < 4; ++d)
#pragma unroll
            for (int g4 = 0; g4 < 4; ++g4) { const f32x4 gv = *(const f32x4*)(a.subln + d * 32 + 8 * g4 + 4 * hi);
                u32x2 w; w.x = pk2(o[d][4 * g4] * rn * gv.x, o[d][4 * g4 + 1] * rn * gv.y); w.y = pk2(o[d][4 * g4 + 2] * rn * gv.z, o[d][4 * g4 + 3] * rn * gv.w);
                *(u32x2*)(op + d * 32 + 8 * g4) = w; }
    }
    __syncthreads();
}
__device__ __forceinline__ void sg_unit(LAS unsigned char* lds, int R0, const bf16_t* SV, bf16_t* U, const float* ng, const bf16_t* sgw, const float* sgb, int tid, int wid, int lane) {
    LAS float* st = (LAS float*)(lds + 139264);
    { u32x4 xs[16];
#pragma unroll
      for (int i = 0; i < 16; ++i) xs[i] = *(const u32x4*)(SV + (size_t)(R0 + wid * 16 + i) * 512 + lane * 8);
#pragma unroll
      for (int i = 0; i < 16; ++i) { const int row = wid * 16 + i; const u32x4 x = xs[i];
        const float f0 = bflo(x.x), f1 = bfhi(x.x), f2 = bflo(x.y), f3 = bfhi(x.y), f4 = bflo(x.z), f5 = bfhi(x.z), f6 = bflo(x.w), f7 = bfhi(x.w);
        const float mean = wave_sum(((f0 + f1) + (f2 + f3)) + ((f4 + f5) + (f6 + f7))) * (1.0f / 512.0f);
        const float d0 = f0 - mean, d1 = f1 - mean, d2 = f2 - mean, d3 = f3 - mean, d4 = f4 - mean, d5 = f5 - mean, d6 = f6 - mean, d7 = f7 - mean;
        const float var = wave_sum(((d0 * d0 + d1 * d1) + (d2 * d2 + d3 * d3)) + ((d4 * d4 + d5 * d5) + (d6 * d6 + d7 * d7))) * (1.0f / 512.0f);
        if (lane == 0) { st[row * 2] = mean; st[row * 2 + 1] = 1.0f / sqrtf(var + EPS); } } }
    __syncthreads();
    { const f32x4 sv = *(const LAS f32x4*)(st + lane * 4);
      u32x4 xa[8], xb[8];
#pragma unroll
      for (int t = 0; t < 8; ++t) { xa[t] = *(const u32x4*)(SV + (size_t)(R0 + 2 * lane) * 512 + (wid * 8 + t) * 8); xb[t] = *(const u32x4*)(SV + (size_t)(R0 + 2 * lane + 1) * 512 + (wid * 8 + t) * 8); }
#pragma unroll
      for (int t = 0; t < 8; ++t) { const int cb = wid * 8 + t;
        const u32x4 x0 = xa[t], x1 = xb[t];
        const f32x4 g0 = *(const f32x4*)(ng + cb * 8), g1 = *(const f32x4*)(ng + cb * 8 + 4);
        LAS unsigned char* wp = lds + (cb * 8) * 272 + lane * 4;
        *(LAS unsigned*)(wp + 0 * 272) = pk2((bflo(x0.x) - sv.x) * sv.y * g0.x, (bflo(x1.x) - sv.z) * sv.w * g0.x);
        *(LAS unsigned*)(wp + 1 * 272) = pk2((bfhi(x0.x) - sv.x) * sv.y * g0.y, (bfhi(x1.x) - sv.z) * sv.w * g0.y);
        *(LAS unsigned*)(wp + 2 * 272) = pk2((bflo(x0.y) - sv.x) * sv.y * g0.z, (bflo(x1.y) - sv.z) * sv.w * g0.z);
        *(LAS unsigned*)(wp + 3 * 272) = pk2((bfhi(x0.y) - sv.x) * sv.y * g0.w, (bfhi(x1.y) - sv.z) * sv.w * g0.w);
        *(LAS unsigned*)(wp + 4 * 272) = pk2((bflo(x0.z) - sv.x) * sv.y * g1.x, (bflo(x1.z) - sv.z) * sv.w * g1.x);
        *(LAS unsigned*)(wp + 5 * 272) = pk2((bfhi(x0.z) - sv.x) * sv.y * g1.y, (bfhi(x1.z) - sv.z) * sv.w * g1.y);
        *(LAS unsigned*)(wp + 6 * 272) = pk2((bflo(x0.w) - sv.x) * sv.y * g1.z, (bflo(x1.w) - sv.z) * sv.w * g1.z);
        *(LAS unsigned*)(wp + 7 * 272) = pk2((bfhi(x0.w) - sv.x) * sv.y * g1.w, (bfhi(x1.w) - sv.z) * sv.w * g1.w); } }
    __syncthreads();
    { const int g = wid >> 1, ph = wid & 1, r32 = lane & 31, hi = lane >> 5;
      for (int pbi = 0; pbi < 2; ++pbi) { const int pcol = (ph * 2 + pbi) * 32 + r32;
        f32x16 acc[4];
#pragma unroll
        for (int d = 0; d < 4; ++d)
#pragma unroll
            for (int r = 0; r < 16; ++r) acc[d][r] = 0.f;
        const bf16_t* wrow = sgw + ((size_t)g * 128 + pcol) * 128 + hi * 8;
        const LAS unsigned char* ap = lds + (g * 128 + r32) * 272 + hi * 16;
#pragma unroll
        for (int ks = 0; ks < 8; ++ks) { const bf16x8 bf = *(const bf16x8*)(wrow + ks * 16);
#pragma unroll
            for (int d = 0; d < 4; ++d) { const bf16x8 af = *(const LAS bf16x8*)(ap + d * 32 * 272 + ks * 32); acc[d] = __builtin_amdgcn_mfma_f32_32x32x16_bf16(af, bf, acc[d], 0, 0, 0); } }
        const float bias = sgb[g * 128 + pcol];
        bf16_t* up = U + (size_t)(R0 + pcol) * 512 + g * 128 + 4 * hi;
#pragma unroll
        for (int d = 0; d < 4; ++d)
#pragma unroll
            for (int g4 = 0; g4 < 4; ++g4) { const u32x2 uu = *(const u32x2*)(up + d * 32 + 8 * g4);
                u32x2 w; w.x = pk2(bflo(uu.x) * (acc[d][4 * g4] + bias), bfhi(uu.x) * (acc[d][4 * g4 + 1] + bias)); w.y = pk2(bflo(uu.y) * (acc[d][4 * g4 + 2] + bias), bfhi(uu.y) * (acc[d][4 * g4 + 3] + bias));
                *(u32x2*)(up + d * 32 + 8 * g4) = w; } } }
    __syncthreads();
}
__device__ __forceinline__ void mixer_phase(const Params& p, int layer, bool last, LAS unsigned char* lds, int tid, int wid, int lane) {
    AttnArgs a; a.Q = (const bf16_t*)(p.ws + WS_Q); a.K = (const bf16_t*)(p.ws + WS_K); a.VT = (const bf16_t*)(p.ws + WS_VT); a.O = (bf16_t*)(p.ws + WS_O);
    a.subln = p.in[12] + layer * 128; a.lam = ((const float*)(p.ws + WS_LAM))[layer]; a.oscale = 1.0f - ((const LAS float*)(lds + 143360 + 200))[layer];
    const int n_ctx_att = last ? 0 : 128, n_sg = last ? 256 : 288, n_items = 1024 + n_ctx_att + n_sg, G = gridDim.x;
    for (int rep = 0; rep < (DUP_ATTN ? 2 : 1); ++rep)
    for (int it = blockIdx.x; it < (rep == 0 ? n_items : 1024); it += G) {
        if (it < 1024) {
            int bh, qblk;
            if (G == 256) { const int c = it & 255, round = it >> 8, x = c & 7, slot = c >> 3; bh = round * 16 + x * 2 + (slot >> 4); qblk = slot & 15; } else { bh = it >> 4; qblk = it & 15; }
            attn_unit(lds, a, bh >> 2, bh & 3, (bh >> 2) * SEQ + qblk * 128, 36, tid, wid, lane);
        } else if (it < 1024 + n_ctx_att) { const int r = it - 1024, bh = r >> 1, half = r & 1;
            attn_unit(lds, a, bh >> 2, bh & 3, RL + (bh >> 2) * CTXL + half * 128, 4, tid, wid, lane);
        } else { const int n = it - 1024 - n_ctx_att;
            sg_unit(lds, n * 128, (const bf16_t*)(p.ws + WS_SV), (bf16_t*)(p.ws + WS_U), p.in[13] + layer * 512, (const bf16_t*)(p.ws + WS_SGW) + (size_t)layer * 4 * 128 * 128, p.in[15] + layer * 512, tid, wid, lane);
        }
    }
}
__device__ __forceinline__ void final_phase(const Params& p, int wid, int lane) {
    const float* g = p.in[22]; const int gw = blockIdx.x * 8 + wid, NGW = gridDim.x * 8;
    for (int r = gw; r < RL; r += NGW) { float* xr = p.out + (size_t)r * DM;
        f32x4 v[4]; float ss = 0.f;
#pragma unroll
        for (int j = 0; j < 4; ++j) { v[j] = ((const f32x4*)xr)[lane + 64 * j]; ss += (v[j].x * v[j].x + v[j].y * v[j].y) + (v[j].z * v[j].z + v[j].w * v[j].w); }
        const float rstd = 1.0f / sqrtf(wave_sum(ss) * (1.0f / DM) + EPS);
#pragma unroll
        for (int j = 0; j < 4; ++j) ((f32x4*)xr)[lane + 64 * j] = (v[j] * rstd) * ((const f32x4*)g)[lane + 64 * j]; }
}

typedef unsigned gu32_unused_t;
#define RLX_AGENT __ATOMIC_RELAXED, __HIP_MEMORY_SCOPE_AGENT
#define XB_TMO      128
#define XB_XCNT(j)  (256  + 64 * (j))
#define XB_XSUB(j)  (1280 + 64 * (j))
#define XB_XGEN(j)  (2304 + 64 * (j))
#define XB_TOP      3328
#define XB_TOPGEN   3392
#define XCD_BAR_WORDS 3456
#define XB_SPIN_CAP (1u << 18)

__device__ __forceinline__ unsigned xb_ld(unsigned* p)              { return __hip_atomic_load(p, __ATOMIC_RELAXED, __HIP_MEMORY_SCOPE_AGENT); }
__device__ __forceinline__ unsigned xb_add(unsigned* p, unsigned v) { return __hip_atomic_fetch_add(p, v, __ATOMIC_RELAXED, __HIP_MEMORY_SCOPE_AGENT); }
__device__ __forceinline__ unsigned xb_xcc_id() { return (unsigned)__builtin_amdgcn_s_getreg((3 << 11) | 20) & 0xFu; }
#define XB_SPIN(cond, bar) do { unsigned _sp = 0; while (cond) { __builtin_amdgcn_s_sleep(1); \
    if ((++_sp & 255u) == 0u) { if (xb_ld(&(bar)[XB_TMO])) break; if (_sp > XB_SPIN_CAP) { atomicAdd(&(bar)[XB_TMO], 1u); break; } } } } while (0)
struct XcdBarrier {
    unsigned* bar; unsigned x;
    volatile LAS unsigned* st;
};

__device__ __forceinline__ XcdBarrier xcd_barrier_post(unsigned* bar, volatile LAS unsigned* st) {
    XcdBarrier b; b.bar = bar; b.x = xb_xcc_id(); b.st = st;
    if (threadIdx.x == 0) (void)xb_add(&bar[XB_XCNT(b.x)], 1u);
    return b;
}
__device__ __forceinline__ void xcd_barrier_complete(unsigned* bar, unsigned x, unsigned& nloc, unsigned& nx) {
    const unsigned G = gridDim.x * gridDim.y * gridDim.z;
    unsigned sum, cnt, mine, sp = 0u;
    for (;;) {
        sum = 0u; cnt = 0u; mine = 0u;
#pragma unroll
        for (unsigned j = 0; j < 16; ++j) { const unsigned c = xb_ld(&bar[XB_XCNT(j)]); sum += c; cnt += (c > 0u) ? 1u : 0u; mine = (j == x) ? c : mine; }
        if (sum == G) break;
        __builtin_amdgcn_s_sleep(1);
        if ((++sp & 255u) == 0u) { if (xb_ld(&bar[XB_TMO])) break; if (sp > XB_SPIN_CAP) { atomicAdd(&bar[XB_TMO], 1u); break; } }
    }
    nloc = mine > 0u ? mine : 1u; nx = cnt > 0u ? cnt : 1u;
}

__device__ __forceinline__ void xcd_barrier(const XcdBarrier& b) {
    asm volatile("s_waitcnt vmcnt(0)" ::: "memory");
    __syncthreads();
    if (threadIdx.x == 0) {
        unsigned* bar = b.bar;
        __builtin_amdgcn_s_waitcnt(0);
        unsigned nloc = b.st[0], nx = b.st[1];
        if (nloc == 0u) { xcd_barrier_complete(bar, b.x, nloc, nx); b.st[0] = nloc; b.st[1] = nx; }
        const unsigned old = xb_add(&bar[XB_XSUB(b.x)], 1u);
        const unsigned gen = old / nloc;
        if (old + 1u == (gen + 1u) * nloc) {
            __builtin_amdgcn_fence(__ATOMIC_RELEASE, "agent");
            asm volatile("s_waitcnt vmcnt(0)" ::: "memory");
            const unsigned og = xb_add(&bar[XB_TOP], 1u);
            const unsigned tg = og / nx;
            if (og + 1u == (tg + 1u) * nx) xb_add(&bar[XB_TOPGEN], 1u);
            else XB_SPIN(xb_ld(&bar[XB_TOPGEN]) == tg, bar);
            __builtin_amdgcn_fence(__ATOMIC_ACQUIRE, "agent");
            xb_add(&bar[XB_XGEN(b.x)], 1u);
            asm volatile("s_waitcnt vmcnt(0)" ::: "memory");
        } else {
            XB_SPIN(xb_ld(&bar[XB_XGEN(b.x)]) == gen, bar);
            __builtin_amdgcn_fence(__ATOMIC_ACQUIRE, "agent");
            asm volatile("s_waitcnt vmcnt(0)" ::: "memory");
        }
    }
    __syncthreads();
}

constexpr int LDSP_OFF = 143360;
__device__ __forceinline__ unsigned long long ldsp64(LAS const unsigned* P, int i) {
    const unsigned lo = __builtin_amdgcn_readfirstlane(P[2 * i]), hi = __builtin_amdgcn_readfirstlane(P[2 * i + 1]); return ((unsigned long long)hi << 32) | lo; }
__device__ __forceinline__ Params load_params(LAS unsigned char* lds) {
    LAS const unsigned* P = (LAS const unsigned*)(lds + LDSP_OFF);
    Params q;
    q.in[0] = (const float*)(const __attribute__((address_space(1))) float*)ldsp64(P, 0);
    q.in[1] = (const float*)(const __attribute__((address_space(1))) float*)ldsp64(P, 1);
    q.in[2] = (const float*)(const __attribute__((address_space(1))) float*)ldsp64(P, 2);
    q.in[3] = (const float*)(const __attribute__((address_space(1))) float*)ldsp64(P, 3);
    q.in[4] = (const float*)(const __attribute__((address_space(1))) float*)ldsp64(P, 4);
    q.in[5] = (const float*)(const __attribute__((address_space(1))) float*)ldsp64(P, 5);
    q.in[6] = (const float*)(const __attribute__((address_space(1))) float*)ldsp64(P, 6);
    q.in[7] = (const float*)(const __attribute__((address_space(1))) float*)ldsp64(P, 7);
    q.in[8] = (const float*)(const __attribute__((address_space(1))) float*)ldsp64(P, 8);
    q.in[9] = (const float*)(const __attribute__((address_space(1))) float*)ldsp64(P, 9);
    q.in[10] = (const float*)(const __attribute__((address_space(1))) float*)ldsp64(P, 10);
    q.in[11] = (const float*)(const __attribute__((address_space(1))) float*)ldsp64(P, 11);
    q.in[12] = (const float*)(const __attribute__((address_space(1))) float*)ldsp64(P, 12);
    q.in[13] = (const float*)(const __attribute__((address_space(1))) float*)ldsp64(P, 13);
    q.in[14] = (const float*)(const __attribute__((address_space(1))) float*)ldsp64(P, 14);
    q.in[15] = (const float*)(const __attribute__((address_space(1))) float*)ldsp64(P, 15);
    q.in[16] = (const float*)(const __attribute__((address_space(1))) float*)ldsp64(P, 16);
    q.in[17] = (const float*)(const __attribute__((address_space(1))) float*)ldsp64(P, 17);
    q.in[18] = (const float*)(const __attribute__((address_space(1))) float*)ldsp64(P, 18);
    q.in[19] = (const float*)(const __attribute__((address_space(1))) float*)ldsp64(P, 19);
    q.in[20] = (const float*)(const __attribute__((address_space(1))) float*)ldsp64(P, 20);
    q.in[21] = (const float*)(const __attribute__((address_space(1))) float*)ldsp64(P, 21);
    q.in[22] = (const float*)(const __attribute__((address_space(1))) float*)ldsp64(P, 22);
    q.out = (float*)(__attribute__((address_space(1))) float*)ldsp64(P, 23); q.ws = (unsigned char*)(__attribute__((address_space(1))) unsigned char*)ldsp64(P, 24);
    q.lam_init[0] = __uint_as_float(__builtin_amdgcn_readfirstlane(P[50]));
    q.lam_init[1] = __uint_as_float(__builtin_amdgcn_readfirstlane(P[51]));
    q.lam_init[2] = __uint_as_float(__builtin_amdgcn_readfirstlane(P[52]));
    q.lam_init[3] = __uint_as_float(__builtin_amdgcn_readfirstlane(P[53]));
    q.lo = 0; q.hi = 0;
    return q;
}
__global__ void __launch_bounds__(512) fwd_kernel(Params kp) {
    extern __shared__ __attribute__((aligned(16))) unsigned char lds_raw[];
    LAS unsigned char* lds = (LAS unsigned char*)lds_raw;
    const int G = gridDim.x, lo = kp.lo, hi = kp.hi;
    if (threadIdx.x == 0) { LAS unsigned long long* P = (LAS unsigned long long*)(lds + LDSP_OFF);
        P[0] = (unsigned long long)kp.in[0];
        P[1] = (unsigned long long)kp.in[1];
        P[2] = (unsigned long long)kp.in[2];
        P[3] = (unsigned long long)kp.in[3];
        P[4] = (unsigned long long)kp.in[4];
        P[5] = (unsigned long long)kp.in[5];
        P[6] = (unsigned long long)kp.in[6];
        P[7] = (unsigned long long)kp.in[7];
        P[8] = (unsigned long long)kp.in[8];
        P[9] = (unsigned long long)kp.in[9];
        P[10] = (unsigned long long)kp.in[10];
        P[11] = (unsigned long long)kp.in[11];
        P[12] = (unsigned long long)kp.in[12];
        P[13] = (unsigned long long)kp.in[13];
        P[14] = (unsigned long long)kp.in[14];
        P[15] = (unsigned long long)kp.in[15];
        P[16] = (unsigned long long)kp.in[16];
        P[17] = (unsigned long long)kp.in[17];
        P[18] = (unsigned long long)kp.in[18];
        P[19] = (unsigned long long)kp.in[19];
        P[20] = (unsigned long long)kp.in[20];
        P[21] = (unsigned long long)kp.in[21];
        P[22] = (unsigned long long)kp.in[22];
        P[23] = (unsigned long long)kp.out; P[24] = (unsigned long long)kp.ws;
        LAS float* Pf = (LAS float*)(lds + LDSP_OFF + 200);
        Pf[0] = kp.lam_init[0]; Pf[1] = kp.lam_init[1]; Pf[2] = kp.lam_init[2]; Pf[3] = kp.lam_init[3];
        volatile LAS unsigned* st = (volatile LAS unsigned*)(lds + LDSP_OFF + 256); st[0] = 0u; st[1] = 0u; }
    __syncthreads();
    if (hi - lo > 2) { const XcdBarrier b0 = xcd_barrier_post((unsigned*)kp.ws, (volatile LAS unsigned*)(lds + LDSP_OFF + 256)); if (threadIdx.x == 0) ((volatile LAS unsigned*)(lds + LDSP_OFF + 256))[2] = b0.x; }
    __syncthreads();
#define FRESH() int tid = threadIdx.x; asm volatile("" : "+v"(tid)); const int lane = tid & 63, wid = __builtin_amdgcn_readfirstlane(tid >> 6); (void)lane; (void)wid; (void)tid; const Params p = load_params(lds); unsigned char* ws = p.ws; (void)ws
    int ph = 0;
#ifndef PHM
#define PHM 0xffff
#endif
#define RUNS(k) ((k) >= lo && (k) < hi)
#define SEAM() do { if (RUNS(ph) && RUNS(ph + 1)) { if (ph == 0) cg::this_grid().sync(); else { XcdBarrier xb_; xb_.bar = (unsigned*)(__attribute__((address_space(1))) unsigned*)ldsp64((LAS const unsigned*)(lds + LDSP_OFF), 24); \
        xb_.x = ((volatile LAS unsigned*)(lds + LDSP_OFF + 256))[2]; xb_.st = (volatile LAS unsigned*)(lds + LDSP_OFF + 256); xcd_barrier(xb_); } } ++ph; } while (0)
    if ((PHM & 1) && RUNS(ph)) { FRESH(); prologue_phase(p, lds, tid, wid, lane); __syncthreads(); convert_layer_weights(p, 0, 0, CV_NIT, blockIdx.x * 8 + wid, gridDim.x * 8, lds, wid, lane); }
    SEAM();
    for (int layer = 0; layer < DEPTH; ++layer) {
        const bool last = layer == DEPTH - 1;
        const int M = last ? RL : RT;
        if ((PHM & 2) && RUNS(ph)) { FRESH(); if (layer > 0) convert_layer_weights(p, layer, G == 256 ? CV_NIT - CV_F2 : 0, CV_NIT, blockIdx.x * 8 + wid, G * 8, lds, wid, lane);
            norm_phase(p, layer, 0, RT, wid, lane); }
        SEAM();
        if ((PHM & 4) && RUNS(ph)) for (int rep = 0; rep < (DUP_GEMM ? 2 : 1); ++rep) { FRESH();
            EpiG1 E{(bf16_t*)(ws + WS_K), (bf16_t*)(ws + WS_VT), (bf16_t*)(ws + WS_Q), (bf16_t*)(ws + WS_U), (bf16_t*)(ws + WS_SV), (bf16_t*)(ws + WS_G), (const float*)(ws + WS_ROPE), 0};
            pg8::Gemm g{(const bf16_t*)(ws + WS_H), (const bf16_t*)(ws + WS_WIN), M, INW, DM}; pg8::StaticOrder S; S.init(M, INW, G, (int)blockIdx.x);
            pg8::gemm_phase<EpiG1, pg8::StaticOrder, true, true>(lds, g, S, E);
            if (last) {
                EpiG1 E2 = E; E2.row_off = RL;
                pg8::Gemm g2{(const bf16_t*)(ws + WS_H) + (size_t)RL * DM, (const bf16_t*)(ws + WS_WIN), RC, 1024, DM}; pg8::StaticOrder S2; S2.init(RC, 1024, G, (int)blockIdx.x);
                pg8::gemm_phase<EpiG1, pg8::StaticOrder, true, true>(lds, g2, S2, E2);
            }
        }
        SEAM();
        if ((PHM & 8) && RUNS(ph)) { FRESH(); mixer_phase(p, layer, last, lds, tid, wid, lane); }
        SEAM();
        if ((PHM & 16) && RUNS(ph)) for (int rep = 0; rep < (DUP_GEMM ? 2 : 1); ++rep) { FRESH();
            pg8::StaticOrder S; S.init(M, DM, G, (int)blockIdx.x);
            { EpiMerge<1> E{(const bf16_t*)(ws + WS_G), (bf16_t*)(ws + WS_H)}; pg8::Gemm g{(const bf16_t*)(ws + WS_O), (const bf16_t*)(ws + WS_WA), M, DM, 512};
              pg8::gemm_phase<EpiMerge<1>, pg8::StaticOrder, true, true>(lds, g, S, E); }
            { EpiMerge<2> E{(const bf16_t*)(ws + WS_G), (bf16_t*)(ws + WS_H)}; pg8::Gemm g{(const bf16_t*)(ws + WS_U), (const bf16_t*)(ws + WS_WSG), M, DM, 512};
              pg8::gemm_phase<EpiMerge<2>, pg8::StaticOrder, true, true>(lds, g, S, E); }
        }
        SEAM();
        if ((PHM & 32) && RUNS(ph)) { FRESH();
            const float* modl = (const float*)(ws + WS_MOD) + (size_t)layer * 17 * 6144;
            const float* xl_in = layer == 0 ? p.in[0] : p.out; const float* xc_in = layer == 0 ? p.in[2] : (const float*)(ws + WS_XC);
            EpiResid E{xl_in, xc_in, p.out, (float*)(ws + WS_XC), modl + 2 * DM};
            pg8::Gemm g{(const bf16_t*)(ws + WS_H), (const bf16_t*)(ws + WS_WO), M, DM, DM}; pg8::StaticOrder S; S.init(M, DM, G, (int)blockIdx.x);
            pg8::gemm_phase<EpiResid, pg8::StaticOrder, true, true>(lds, g, S, E);
        }
        SEAM();
        if ((PHM & 64) && RUNS(ph)) { FRESH(); norm_phase(p, layer, 1, M, wid, lane); }
        SEAM();
        if ((PHM & 128) && RUNS(ph)) for (int rep = 0; rep < (DUP_GEMM ? 2 : 1); ++rep) { FRESH();
            EpiFfn1 E{(bf16_t*)(ws + WS_ACT)};
            pg8::Gemm g{(const bf16_t*)(ws + WS_H), (const bf16_t*)(ws + WS_WF1), M, 2 * DFF, DM}; pg8::StaticOrder S; S.init(M, 2 * DFF, G, (int)blockIdx.x);
            pg8::gemm_phase<EpiFfn1, pg8::StaticOrder, true, true>(lds, g, S, E);
        }
        SEAM();
        if ((PHM & 256) && RUNS(ph)) { FRESH();
            const float* modl = (const float*)(ws + WS_MOD) + (size_t)layer * 17 * 6144;
            EpiResid E{p.out, (const float*)(ws + WS_XC), p.out, (float*)(ws + WS_XC), modl + 5 * DM};
            pg8::Gemm g{(const bf16_t*)(ws + WS_ACT), (const bf16_t*)(ws + WS_WF2), M, DM, DFF}; pg8::StaticOrder S; S.init(M, DM, G, (int)blockIdx.x);
            pg8::gemm_phase<EpiResid, pg8::StaticOrder, true, true>(lds, g, S, E);
            if (!last && G == 256 && blockIdx.x >= 64) convert_layer_weights(p, layer + 1, 0, CV_NIT - CV_F2, ((int)blockIdx.x - 64) * 8 + wid, 192 * 8, lds, wid, lane);
        }
        SEAM();
    }
    if ((PHM & 512) && RUNS(ph)) { FRESH(); final_phase(p, wid, lane); }
#undef RUNS
#undef SEAM
}

extern "C" void kernel_launch(void* const* d_in, const int* in_sizes, int n_in, void* d_out, int out_size, void* d_ws, size_t ws_size, hipStream_t stream) {
    static int grid = 0;
    if (grid == 0) {
        if (n_in != 23 || out_size != RL * DM || ws_size < WS_END) { fprintf(stderr, "kernel_launch: unexpected shapes (n_in %d out %d ws %zu)\n", n_in, out_size, ws_size); grid = -1; return; }
        int dev = 0, cus = 0, per_cu = 0;
        hipGetDevice(&dev); hipDeviceGetAttribute(&cus, hipDeviceAttributeMultiprocessorCount, dev);
        if (hipFuncSetAttribute((const void*)fwd_kernel, hipFuncAttributeMaxDynamicSharedMemorySize, LDS_BYTES) != hipSuccess) { fprintf(stderr, "kernel_launch: hipFuncSetAttribute failed\n"); grid = -1; return; }
        if (hipOccupancyMaxActiveBlocksPerMultiprocessor(&per_cu, (const void*)fwd_kernel, 512, LDS_BYTES) != hipSuccess || per_cu < 1) { fprintf(stderr, "kernel_launch: occupancy query says %d\n", per_cu); per_cu = 1; }
        (void)hipGetLastError();
        grid = cus * per_cu;
        if (grid > 256) grid = 256;
    }
    if (grid < 0) return;
    Params p{};
    for (int i = 0; i < 23; ++i) p.in[i] = (const float*)d_in[i];
    p.out = (float*)d_out; p.ws = (unsigned char*)d_ws;
    for (int i = 0; i < 4; ++i) p.lam_init[i] = (float)(0.8 - 0.6 * std::exp(-0.3 * (double)i));
#if COOP
    if (hipMemsetAsync(d_ws, 0, 16384, stream) != hipSuccess) { fprintf(stderr, "kernel_launch: memset of barrier words failed\n"); return; }
    p.lo = 0; p.hi = NPHASE;
    void* args[] = {&p};
    hipError_t e = hipLaunchCooperativeKernel((const void*)fwd_kernel, dim3(grid), dim3(512), args, LDS_BYTES, stream);
    if (e != hipSuccess) fprintf(stderr, "cooperative launch failed: %s (grid %d)\n", hipGetErrorString(e), grid);
#else
    for (int k = 0; k < NPHASE; ++k) { p.lo = k; p.hi = k + 1; hipLaunchKernelGGL(fwd_kernel, dim3(grid), dim3(512), LDS_BYTES, stream, p); }
#endif
}
```
